# Optimizing an MI355X kernel written in HIP

```python
import math
import jax, jax.numpy as jnp
from jax import lax
import numpy as np

D_MODEL = 1024
BATCH = 4
SEQ = 8192
DEPTH = 2

GRID_W = 64
CTX_LEN = 256
N_EVEN = (DEPTH + 1) // 2
N_ODD = DEPTH // 2
EPS = 1e-6

M_HEADS = 4
M_DK = 128
M_DV = 128
M_CHUNK = 64
B_HEADS = 8
B_Q_RANK = 256
B_KV_RANK = 128
B_NOPE = 64
B_ROPE = 32
B_V = 64
ROPE_BASE = 10000.0
Q_BLOCK = 128
C_HEADS = 16
C_HEAD_DIM = 64
NA_KH_MAX = 8
NA_KW = 16
D_FF = 4 * D_MODEL

M_WIDTH = M_HEADS * M_DV
B_WIDTH = B_HEADS * B_V
AB_WIDTH = M_WIDTH + B_WIDTH
C_WIDTH = C_HEADS * C_HEAD_DIM
AB_SPLITS = (M_HEADS * M_DK, M_HEADS * M_DK, M_HEADS * M_DV, M_HEADS * M_DV, 4 * M_HEADS,
             B_Q_RANK, B_KV_RANK, B_ROPE)
AB_IN = sum(AB_SPLITS)

kernel_name = "hybrid_mlstm_mla_natten_dit_block"


def rmsnorm(x, g):
    xf = x.astype(jnp.float32)
    y = xf * lax.rsqrt(jnp.mean(xf * xf, axis=-1, keepdims=True) + EPS)
    return y.astype(x.dtype) * g


def modulate(x, g, shift, scale):
    return rmsnorm(x, g) * (1 + scale) + shift


def split_cols(a, sizes):
    idx = np.cumsum(np.array(sizes))[:-1].tolist()
    return jnp.split(a, idx, axis=-1)


def sqrelu_mlp(h, w1, w2):
    return jnp.square(jax.nn.relu(h @ w1)) @ w2


def rope_2d(T):
    pos = jnp.arange(T)
    row = (pos // GRID_W).astype(jnp.float32)
    col = (pos % GRID_W).astype(jnp.float32)
    n_f = B_ROPE // 4
    freqs = ROPE_BASE ** (-jnp.arange(n_f, dtype=jnp.float32) / n_f)
    ang = jnp.concatenate([row[:, None] * freqs, col[:, None] * freqs], axis=-1)
    return jnp.cos(ang)[:, None, :], jnp.sin(ang)[:, None, :]


def apply_rope(x, cos, sin):
    half = x.shape[-1] // 2
    xa = x[..., :half].astype(jnp.float32)
    xb = x[..., half:].astype(jnp.float32)
    out = jnp.concatenate([xa * cos - xb * sin, xa * sin + xb * cos], axis=-1)
    return out.astype(x.dtype)


def dense_attention(q, k, v, scale):
    s = jnp.einsum('bqhd,bkhd->bhqk', q, k).astype(jnp.float32) * scale
    p = jax.nn.softmax(s, axis=-1).astype(v.dtype)
    return jnp.einsum('bhqk,bkhd->bqhd', p, v)


def blocked_attention(q, k, v, scale):
    B, T, H, dq = q.shape
    nb = T // Q_BLOCK
    qb = jnp.moveaxis(q.reshape(B, nb, Q_BLOCK, H, dq), 1, 0)
    o = lax.map(lambda qi: dense_attention(qi, k, v, scale), qb)
    return jnp.moveaxis(o, 0, 1).reshape(B, T, H, v.shape[-1])


def mlstm_zero_state(B):
    return (jnp.zeros((B, M_HEADS, M_DK, M_DV), jnp.float32),
            jnp.zeros((B, M_HEADS, M_DK), jnp.float32),
            jnp.zeros((B, M_HEADS), jnp.float32))


def mlstm_chunked(q, k, v, log_i, log_f, state):
    B, H, T, _ = q.shape
    L = M_CHUNK
    nc = T // L

    def chunks(a):
        return jnp.moveaxis(a.reshape(a.shape[:2] + (nc, L) + a.shape[3:]), 2, 0)

    tril = jnp.tril(jnp.ones((L, L), dtype=bool))

    def step(carry, inp):
        C, n, m = carry
        qc, kc, vc, li, lf = inp
        b = jnp.cumsum(lf, axis=-1)
        d_mat = jnp.where(tril, b[..., :, None] - b[..., None, :] + li[..., None, :], -jnp.inf)
        inter = b + m[..., None]
        m_t = jnp.maximum(jnp.max(d_mat, axis=-1), inter)
        s = jnp.einsum('bhtd,bhsd->bhts', qc, kc) * jnp.exp(d_mat - m_t[..., None])
        w_inter = jnp.exp(inter - m_t)
        num = (w_inter[..., None] * jnp.einsum('bhtd,bhde->bhte', qc, C)
               + jnp.einsum('bhts,bhse->bhte', s, vc))
        den = w_inter * jnp.einsum('bhtd,bhd->bht', qc, n) + jnp.sum(s, axis=-1)
        h = num / jnp.maximum(jnp.abs(den), jnp.exp(-m_t))[..., None]
        b_last = b[..., -1]
        g = b_last[..., None] - b + li
        m_new = jnp.maximum(b_last + m, jnp.max(g, axis=-1))
        w_k = jnp.exp(g - m_new[..., None])
        decay = jnp.exp(b_last + m - m_new)
        C_new = decay[..., None, None] * C + jnp.einsum('bhs,bhsd,bhse->bhde', w_k, kc, vc)
        n_new = decay[..., None] * n + jnp.einsum('bhs,bhsd->bhd', w_k, kc)
        return (C_new, n_new, m_new), h

    state, hs = lax.scan(step, state, (chunks(q), chunks(k), chunks(v), chunks(log_i), chunks(log_f)))
    h = jnp.moveaxis(hs, 0, 2).reshape(B, H, T, v.shape[-1])
    return h, state


def mlstm_bidir(q, k, v, gates, states):
    i_f, f_f, i_b, f_b = gates
    h_f, s_f = mlstm_chunked(q, k, v, i_f, f_f, states[0])
    flip = lambda a: jnp.flip(a, axis=2)
    h_b, s_b = mlstm_chunked(flip(q), flip(k), flip(v), flip(i_b), flip(f_b), states[1])
    return h_f + flip(h_b), (s_f, s_b)


def mlstm_heads(a, d):
    B, T, _ = a.shape
    return a.reshape(B, T, M_HEADS, d).transpose(0, 2, 1, 3).astype(jnp.float32)


def mlstm_gates(pre, gate_b):
    B, T, _ = pre.shape
    g = (pre + gate_b).astype(jnp.float32).reshape(B, T, 4, M_HEADS).transpose(2, 0, 3, 1)
    return (g[0], jax.nn.log_sigmoid(g[1]), g[2], jax.nn.log_sigmoid(g[3]))


def mlstm_out(hm, o, norm_g):
    B, H, T, dv = hm.shape
    hn = rmsnorm(hm, norm_g[:, None, :]).transpose(0, 2, 1, 3).reshape(B, T, H * dv)
    return (hn * jax.nn.sigmoid(o.astype(jnp.float32))).astype(o.dtype)


def mla_qkv(cq, ckv, kr, q_norm_g, kv_norm_g, w_uq, w_ukv, rope):
    B, T, _ = cq.shape
    q = (rmsnorm(cq, q_norm_g) @ w_uq).reshape(B, T, B_HEADS, B_NOPE + B_ROPE)
    kv = (rmsnorm(ckv, kv_norm_g) @ w_ukv).reshape(B, T, B_HEADS, B_NOPE + B_V)
    q_nope, q_rope = q[..., :B_NOPE], q[..., B_NOPE:]
    k_nope, v = kv[..., :B_NOPE], kv[..., B_NOPE:]
    k_rope = kr[:, :, None, :]
    if rope is not None:
        q_rope = apply_rope(q_rope, *rope)
        k_rope = apply_rope(k_rope, *rope)
    q = jnp.concatenate([q_nope, q_rope], axis=-1)
    k = jnp.concatenate([k_nope, jnp.broadcast_to(k_rope, k_nope.shape[:-1] + (B_ROPE,))], axis=-1)
    return q, k, v


def mixer_ab(h, hc, w_in, gate_b, m_norm_g, q_norm_g, kv_norm_g, w_uq, w_ukv, rope, ctx_out):
    B, T, _ = h.shape
    mq, mk, mv, mo, mg, cq, ckv, kr = split_cols(h @ w_in, AB_SPLITS)
    mq_c, mk_c, mv_c, mo_c, mg_c, cq_c, ckv_c, kr_c = split_cols(hc @ w_in, AB_SPLITS)
    zero = mlstm_zero_state(B)
    q_scale = M_DK ** -0.5
    h_mc, ctx_states = mlstm_bidir(mlstm_heads(mq_c, M_DK) * q_scale, mlstm_heads(mk_c, M_DK),
                                   mlstm_heads(mv_c, M_DV), mlstm_gates(mg_c, gate_b), (zero, zero))
    h_ml, _ = mlstm_bidir(mlstm_heads(mq, M_DK) * q_scale, mlstm_heads(mk, M_DK),
                          mlstm_heads(mv, M_DV), mlstm_gates(mg, gate_b), ctx_states)
    m_lat = mlstm_out(h_ml, mo, m_norm_g)
    a_scale = (B_NOPE + B_ROPE) ** -0.5
    q_l, k_l, v_l = mla_qkv(cq, ckv, kr, q_norm_g, kv_norm_g, w_uq, w_ukv, rope)
    q_c, k_c, v_c = mla_qkv(cq_c, ckv_c, kr_c, q_norm_g, kv_norm_g, w_uq, w_ukv, None)
    b_lat = blocked_attention(q_l, jnp.concatenate([k_l, k_c], axis=1),
                              jnp.concatenate([v_l, v_c], axis=1), a_scale).reshape(B, T, B_WIDTH)
    y_lat = jnp.concatenate([m_lat, b_lat.astype(m_lat.dtype)], axis=-1)
    if not ctx_out:
        return y_lat, None
    m_ctx = mlstm_out(h_mc, mo_c, m_norm_g)
    b_ctx = dense_attention(q_c, k_c, v_c, a_scale).reshape(B, hc.shape[1], B_WIDTH)
    return y_lat, jnp.concatenate([m_ctx, b_ctx.astype(m_ctx.dtype)], axis=-1)


def na_mixer(h, hc, w_in, rel_bias, ctx_out):
    B, T, _ = h.shape
    rows = T // GRID_W
    H, d = C_HEADS, C_HEAD_DIM
    scale = d ** -0.5
    q, k, v = [a.reshape(B, T, H, d) for a in jnp.split(h @ w_in, 3, axis=-1)]
    qc, kc, vc = [a.reshape(B, hc.shape[1], H, d) for a in jnp.split(hc @ w_in, 3, axis=-1)]
    kh = min(NA_KH_MAX, rows)
    nwin = kh * NA_KW
    row_start = jnp.clip(jnp.arange(rows) - kh // 2, 0, rows - kh)
    col_idx = jnp.clip(jnp.arange(GRID_W) - NA_KW // 2, 0, GRID_W - NA_KW)[:, None] + jnp.arange(NA_KW)
    ci = col_idx - jnp.arange(GRID_W)[:, None] + NA_KW - 1
    k_grid = k.reshape(B, rows, GRID_W, H, d)
    v_grid = v.reshape(B, rows, GRID_W, H, d)
    q_rows = jnp.moveaxis(q.reshape(B, rows, GRID_W, H, d), 1, 0)

    def row_block(args):
        qr, r, rs = args
        kr = lax.dynamic_slice_in_dim(k_grid, rs, kh, axis=1)[:, :, col_idx]
        vr = lax.dynamic_slice_in_dim(v_grid, rs, kh, axis=1)[:, :, col_idx]
        ri = rs + jnp.arange(kh) - r + NA_KH_MAX - 1
        bias = rel_bias[:, ri[:, None, None], ci[None, :, :]]
        bias = bias.transpose(0, 2, 1, 3).reshape(H, GRID_W, nwin)
        s_win = jnp.einsum('bqhd,bxqyhd->bhqxy', qr, kr).reshape(B, H, GRID_W, nwin) * scale + bias
        s_ctx = jnp.einsum('bqhd,bkhd->bhqk', qr, kc) * scale
        p = jax.nn.softmax(jnp.concatenate([s_win, s_ctx], axis=-1).astype(jnp.float32), axis=-1)
        p = p.astype(v.dtype)
        p_win = p[..., :nwin].reshape(B, H, GRID_W, kh, NA_KW)
        return (jnp.einsum('bhqxy,bxqyhd->bqhd', p_win, vr)
                + jnp.einsum('bhqk,bkhd->bqhd', p[..., nwin:], vc))

    o = lax.map(row_block, (q_rows, jnp.arange(rows), row_start))
    y_lat = jnp.moveaxis(o, 0, 1).reshape(B, T, C_WIDTH)
    if not ctx_out:
        return y_lat, None
    y_ctx = dense_attention(qc, kc, vc, scale).reshape(B, hc.shape[1], C_WIDTH)
    return y_lat, y_ctx


def setup_inputs(seed: int = 0) -> dict:
    key = jax.random.key(seed)
    ks = jax.random.split(key, 24)
    f32 = jnp.float32
    nrm = lambda k, shape, s: jax.random.normal(k, shape, f32) * s
    gain = lambda k, shape: 1.0 + nrm(k, shape, 0.02)
    f_bias = jnp.linspace(3.0, 6.0, M_HEADS, dtype=f32)
    gate_base = jnp.concatenate([jnp.zeros((M_HEADS,), f32), f_bias, jnp.zeros((M_HEADS,), f32), f_bias])
    return {
        "x": nrm(ks[0], (BATCH, SEQ, D_MODEL), 1.0),
        "c": nrm(ks[1], (BATCH, D_MODEL), 1.0),
        "ctx": nrm(ks[2], (BATCH, CTX_LEN, D_MODEL), 1.0),
        "c_ctx": nrm(ks[3], (D_MODEL,), 1.0),
        "ada_w": nrm(ks[4], (DEPTH, D_MODEL, 6 * D_MODEL), 0.5 * D_MODEL ** -0.5),
        "ada_b": nrm(ks[5], (DEPTH, 6 * D_MODEL), 0.02),
        "norm1_g": gain(ks[6], (DEPTH, D_MODEL)),
        "norm2_g": gain(ks[7], (DEPTH, D_MODEL)),
        "mlp_w1": nrm(ks[8], (DEPTH, D_MODEL, D_FF), D_MODEL ** -0.5),
        "mlp_w2": nrm(ks[9], (DEPTH, D_FF, D_MODEL), D_FF ** -0.5),
        "ab_w_in": nrm(ks[10], (N_EVEN, D_MODEL, AB_IN), D_MODEL ** -0.5),
        "ab_gate_b": gate_base + nrm(ks[11], (N_EVEN, 4 * M_HEADS), 0.1),
        "ab_m_norm_g": gain(ks[12], (N_EVEN, M_HEADS, M_DV)),
        "ab_q_norm_g": gain(ks[13], (N_EVEN, B_Q_RANK)),
        "ab_kv_norm_g": gain(ks[14], (N_EVEN, B_KV_RANK)),
        "ab_w_uq": nrm(ks[15], (N_EVEN, B_Q_RANK, B_HEADS * (B_NOPE + B_ROPE)), B_Q_RANK ** -0.5),
        "ab_w_ukv": nrm(ks[16], (N_EVEN, B_KV_RANK, B_HEADS * (B_NOPE + B_V)), B_KV_RANK ** -0.5),
        "ab_w_out": nrm(ks[17], (N_EVEN, AB_WIDTH, D_MODEL), AB_WIDTH ** -0.5),
        "na_w_in": nrm(ks[18], (N_ODD, D_MODEL, 3 * C_WIDTH), D_MODEL ** -0.5),
        "na_rel_bias": nrm(ks[19], (N_ODD, C_HEADS, 2 * NA_KH_MAX - 1, 2 * NA_KW - 1), 0.5),
        "na_w_out": nrm(ks[20], (N_ODD, C_WIDTH, D_MODEL), C_WIDTH ** -0.5),
        "final_norm_g": gain(ks[21], (D_MODEL,)),
    }


def reference(x, c, ctx, c_ctx, ada_w, ada_b, norm1_g, norm2_g, mlp_w1, mlp_w2,
              ab_w_in, ab_gate_b, ab_m_norm_g, ab_q_norm_g, ab_kv_norm_g, ab_w_uq, ab_w_ukv, ab_w_out,
              na_w_in, na_rel_bias, na_w_out, final_norm_g):
    T = x.shape[1]
    rope = rope_2d(T)
    for i in range(DEPTH):
        ctx_out = i < DEPTH - 1
        mod = jax.nn.silu(c) @ ada_w[i] + ada_b[i]
        mod_c = jax.nn.silu(c_ctx) @ ada_w[i] + ada_b[i]
        sh1, sc1, g1, sh2, sc2, g2 = jnp.split(mod[:, None, :], 6, axis=-1)
        csh1, csc1, cg1, csh2, csc2, cg2 = jnp.split(mod_c, 6, axis=-1)
        h = modulate(x, norm1_g[i], sh1, sc1)
        hc = modulate(ctx, norm1_g[i], csh1, csc1)
        if i % 2 == 0:
            e = i // 2
            y, yc = mixer_ab(h, hc, ab_w_in[e], ab_gate_b[e], ab_m_norm_g[e], ab_q_norm_g[e],
                             ab_kv_norm_g[e], ab_w_uq[e], ab_w_ukv[e], rope, ctx_out)
            w_out = ab_w_out[e]
        else:
            o = i // 2
            y, yc = na_mixer(h, hc, na_w_in[o], na_rel_bias[o], ctx_out)
            w_out = na_w_out[o]
        x = x + g1 * (y @ w_out)
        x = x + g2 * sqrelu_mlp(modulate(x, norm2_g[i], sh2, sc2), mlp_w1[i], mlp_w2[i])
        if ctx_out:
            ctx = ctx + cg1 * (yc @ w_out)
            ctx = ctx + cg2 * sqrelu_mlp(modulate(ctx, norm2_g[i], csh2, csc2), mlp_w1[i], mlp_w2[i])
    return rmsnorm(x, final_norm_g)
```

```cpp
#include <hip/hip_runtime.h>
#include <hip/hip_cooperative_groups.h>
#include <cstdio>
#include <cstdint>
namespace cg = cooperative_groups;
namespace pg8 {
#define PG8_LAS __attribute__((address_space(3)))
typedef unsigned short bf16_t;
typedef short bf16x8 __attribute__((ext_vector_type(8)));
typedef float f32x4 __attribute__((ext_vector_type(4)));
typedef unsigned u32x4 __attribute__((ext_vector_type(4)));
constexpr int BM = 256, BK = 64, HALF = 128, HTB = HALF * BK * 2  , STAGE_BYTES = 8 * HTB, NXCD = 8, WGM = 8;

__host__ __device__ __forceinline__ int lds_byte(int r, int c) { const int st = (r >> 4) * 2 + (c >> 5), rr = r & 15, cc = c & 31, ob = rr * 64 + cc * 2; return st * 1024 + (ob ^ (((ob >> 9) & 1) << 5)); }
__host__ __device__ __forceinline__ void stage_rc(int b, int& R, int& C) { const int st = b / 1024, sb = b % 1024, swz = sb ^ (((sb >> 9) & 1) << 5); R = (st >> 1) * 16 + swz / 64; C = (st & 1) * 32 + (swz % 64) / 2; }
__host__ __device__ __forceinline__ int perm32(int rho) { const int n = rho >> 4, i = rho & 15; return 8 * (i >> 2) + 4 * n + (i & 3); }

struct Unit { int pm, pn; };
struct Gemm { const bf16_t* A; const bf16_t* Bt; int M, N, K, ld; };

struct StaticOrder {
    int nM, nN, nwg, G, c;
    __host__ __device__ void init(int M, int N, int G_, int c_) { nM = M / BM; nN = N / BM; nwg = nM * nN; G = G_; c = c_; }
    __host__ __device__ bool next(int i, Unit& u) const {
        const long L = (long)i * G + c; if (L >= nwg) return false;
        int wgid = (int)L; { const int q = nwg / NXCD, r = nwg % NXCD, xcd = wgid % NXCD, off = wgid / NXCD; wgid = (xcd < r ? xcd * (q + 1) : r * (q + 1) + (xcd - r) * q) + off; }
        const int nig = WGM * nN, gid = wgid / nig, fm = gid * WGM, gsz = (nM - fm) < WGM ? (nM - fm) : WGM;
        u.pm = fm + ((wgid % nig) % gsz); u.pn = (wgid % nig) / gsz; return true;
    }
    __device__ __forceinline__ void a_ready(const Unit&) const {}
    __device__ __forceinline__ void done(const Unit&) const {}
};

__device__ __forceinline__ unsigned cvt_pk_bf16(float lo, float hi) { unsigned r; asm volatile("v_cvt_pk_bf16_f32 %0, %1, %2" : "=v"(r) : "v"(lo), "v"(hi)); return r; }
typedef float f32x2 __attribute__((ext_vector_type(2)));
template <class Epi, class Sched, bool ALIGN_EPI = false, bool SP2 = false>
__device__ __forceinline__ void gemm_phase(PG8_LAS unsigned char* lds, const Gemm g, const Sched& S, const Epi& E) {
    const int tid = threadIdx.x, wid = __builtin_amdgcn_readfirstlane(tid >> 6), lane = tid & 63, wr = wid >> 2, wc = wid & 3, fr = lane & 15, fq = lane >> 4;
    const int K = g.K, LD = g.ld, nt = K / BK;
    unsigned voffA[2], voffB[2];
#pragma unroll
    for (int i = 0; i < 2; ++i) { int R, C; stage_rc(tid * 16 + i * 8192, R, C); const int Rb = Epi::PERM ? ((R & ~31) + perm32(R & 31)) : R;
        voffA[i] = (unsigned)(R * LD + C) * 2u; voffB[i] = (unsigned)(Rb * LD + C) * 2u; }
    const size_t kstep = (size_t)(BK * 2);
    const size_t hstep = (size_t)HALF * LD * 2;
    const size_t tstep = 2 * hstep;
    const unsigned ldsw = (unsigned)wid * 1024u;
    const int aoff = lds_byte(wr * 64 + fr, fq * 8), boff = lds_byte(wc * 32 + fr, fq * 8);
#define PG8_SA(b, h) (((b) * 2 + (h)) * HTB)
#define PG8_SB(b, h) ((4 + (b) * 2 + (h)) * HTB)
#define PG8_STAGE(bufoff, gbase, voff) do { _Pragma("unroll") for (int _i = 0; _i < 2; ++_i) \
        __builtin_amdgcn_global_load_lds((const unsigned*)((const char*)(gbase) + (voff)[_i]), (PG8_LAS unsigned*)(lds + (bufoff) + ldsw + _i * 8192), 16, 0, 0); } while (0)
#define PG8_LDA(dst, b, h) do { _Pragma("unroll") for (int m = 0; m < 4; ++m) _Pragma("unroll") for (int k = 0; k < 2; ++k) dst[m][k] = *(const PG8_LAS bf16x8*)(lds + PG8_SA(b, h) + aoff + m * 2048 + k * 1024); } while (0)
#define PG8_LDB(dst, b, h) do { _Pragma("unroll") for (int n = 0; n < 2; ++n) _Pragma("unroll") for (int k = 0; k < 2; ++k) dst[n][k] = *(const PG8_LAS bf16x8*)(lds + PG8_SB(b, h) + boff + n * 2048 + k * 1024); } while (0)
#define PG8_MMA(ai, bj, At, Bt) do { __builtin_amdgcn_s_setprio(1); _Pragma("unroll") for (int m = 0; m < 4; ++m) _Pragma("unroll") for (int n = 0; n < 2; ++n) _Pragma("unroll") for (int k = 0; k < 2; ++k) \
        acc[ai][bj][m][n] = __builtin_amdgcn_mfma_f32_16x16x32_bf16(Bt[n][k], At[m][k], acc[ai][bj][m][n], 0, 0, 0); __builtin_amdgcn_s_setprio(0); } while (0)
#define PG8_WAIT_V(n) asm volatile("s_waitcnt vmcnt(" #n ")" ::: "memory")
#define PG8_WAIT_L(n) asm volatile("s_waitcnt lgkmcnt(" #n ")" ::: "memory")
#define PG8_BAR __builtin_amdgcn_s_barrier()
#define PG8_SCHED __builtin_amdgcn_sched_barrier(0)
    Unit cur, nxt; int ui = 0;
    if (!S.next(0, cur)) return;
    f32x4 acc[2][2][4][2];
#pragma unroll
    for (int a = 0; a < 2; ++a)
#pragma unroll
        for (int b = 0; b < 2; ++b)
#pragma unroll
            for (int m = 0; m < 4; ++m)
#pragma unroll
                for (int n = 0; n < 2; ++n) acc[a][b][m][n] = (f32x4){0.f, 0.f, 0.f, 0.f};
    bf16x8 At[4][2], B0[2][2], B1[2][2];
    const char* cA = (const char*)g.A + (size_t)cur.pm * tstep; const char* cB = (const char*)g.Bt + (size_t)cur.pn * tstep;
    S.a_ready(cur);
    if constexpr (SP2) {
        PG8_STAGE(PG8_SB(0, 0), cB, voffB); PG8_STAGE(PG8_SB(0, 1), cB + hstep, voffB); PG8_STAGE(PG8_SA(0, 0), cA, voffA); PG8_STAGE(PG8_SA(0, 1), cA + hstep, voffA);
        if (wr == 1) PG8_BAR;
        PG8_WAIT_V(2); PG8_BAR;
        PG8_STAGE(PG8_SB(1, 0), cB + kstep, voffB); PG8_STAGE(PG8_SA(1, 0), cA + kstep, voffA); PG8_STAGE(PG8_SB(1, 1), cB + hstep + kstep, voffB);
        PG8_WAIT_V(6); PG8_BAR;
    } else {
        PG8_STAGE(PG8_SB(0, 0), cB, voffB); PG8_STAGE(PG8_SA(0, 0), cA, voffA); PG8_STAGE(PG8_SB(0, 1), cB + hstep, voffB); PG8_STAGE(PG8_SA(0, 1), cA + hstep, voffA);
        if (wr == 1) PG8_BAR;
        PG8_WAIT_V(4); PG8_BAR;
        PG8_STAGE(PG8_SB(1, 0), cB + kstep, voffB); PG8_STAGE(PG8_SA(1, 0), cA + kstep, voffA); PG8_STAGE(PG8_SB(1, 1), cB + hstep + kstep, voffB);
        PG8_WAIT_V(6); PG8_BAR;
    }
    for (;;) {
        const bool has_next = S.next(ui + 1, nxt);
        const char* nA = has_next ? (const char*)g.A + (size_t)nxt.pm * tstep : cA; const char* nB = has_next ? (const char*)g.Bt + (size_t)nxt.pn * tstep : cB;
        for (int t = 0; t < nt; t += 2) {
            const bool last = (t == nt - 2);
            const char* a1 = cA + (size_t)(t + 1) * kstep;
            const char* a2 = last ? nA : cA + (size_t)(t + 2) * kstep; const char* b2 = last ? nB : cB + (size_t)(t + 2) * kstep;
            const char* a3 = a2 + kstep; const char* b3 = b2 + kstep;
            if (last && has_next) S.a_ready(nxt);
            if constexpr (SP2) {
            PG8_LDB(B0, 0, 0); PG8_LDB(B1, 0, 1); PG8_SCHED; PG8_LDA(At, 0, 0); PG8_STAGE(PG8_SA(1, 1), a1 + hstep, voffA);
            PG8_WAIT_V(8); PG8_WAIT_L(0); PG8_BAR; PG8_MMA(0, 0, At, B0); PG8_MMA(0, 1, At, B1); PG8_BAR; PG8_SCHED;
            PG8_LDA(At, 0, 1); PG8_STAGE(PG8_SB(0, 0), b2, voffB); PG8_STAGE(PG8_SB(0, 1), b2 + hstep, voffB); PG8_STAGE(PG8_SA(0, 0), a2, voffA);
            PG8_WAIT_V(8); PG8_WAIT_L(0); PG8_BAR; PG8_MMA(1, 0, At, B0); PG8_MMA(1, 1, At, B1); PG8_BAR; PG8_SCHED;
            PG8_LDB(B0, 1, 0); PG8_LDB(B1, 1, 1); PG8_SCHED; PG8_LDA(At, 1, 0); PG8_STAGE(PG8_SA(0, 1), a2 + hstep, voffA);
            PG8_WAIT_V(8); PG8_WAIT_L(0); PG8_BAR; PG8_MMA(0, 0, At, B0); PG8_MMA(0, 1, At, B1); PG8_BAR; PG8_SCHED;
            PG8_LDA(At, 1, 1); PG8_STAGE(PG8_SB(1, 0), b3, voffB); PG8_STAGE(PG8_SB(1, 1), b3 + hstep, voffB); PG8_STAGE(PG8_SA(1, 0), a3, voffA);
            PG8_WAIT_V(8); PG8_WAIT_L(0); PG8_BAR; PG8_MMA(1, 0, At, B0); PG8_MMA(1, 1, At, B1); PG8_BAR; PG8_SCHED;
            } else {
            PG8_LDB(B0, 0, 0); PG8_SCHED; PG8_LDA(At, 0, 0); PG8_STAGE(PG8_SA(1, 1), a1 + hstep, voffA);
            PG8_WAIT_L(8); PG8_BAR; PG8_WAIT_L(0); PG8_MMA(0, 0, At, B0); PG8_BAR; PG8_SCHED;
            PG8_LDB(B1, 0, 1); PG8_STAGE(PG8_SB(0, 0), b2, voffB);
            PG8_BAR; PG8_WAIT_L(0); PG8_MMA(0, 1, At, B1); PG8_BAR;
            PG8_LDA(At, 0, 1); PG8_STAGE(PG8_SA(0, 0), a2, voffA);
            PG8_BAR; PG8_WAIT_L(0); PG8_MMA(1, 0, At, B0); PG8_BAR; PG8_SCHED;
            PG8_STAGE(PG8_SB(0, 1), b2 + hstep, voffB);
            PG8_WAIT_V(6); PG8_BAR; PG8_MMA(1, 1, At, B1); PG8_BAR;
            PG8_LDB(B0, 1, 0); PG8_SCHED; PG8_LDA(At, 1, 0); PG8_STAGE(PG8_SA(0, 1), a2 + hstep, voffA);
            PG8_WAIT_L(8); PG8_BAR; PG8_WAIT_L(0); PG8_MMA(0, 0, At, B0); PG8_BAR; PG8_SCHED;
            PG8_LDB(B1, 1, 1); PG8_STAGE(PG8_SB(1, 0), b3, voffB);
            PG8_BAR; PG8_WAIT_L(0); PG8_MMA(0, 1, At, B1); PG8_BAR;
            PG8_LDA(At, 1, 1); PG8_STAGE(PG8_SA(1, 0), a3, voffA);
            PG8_BAR; PG8_WAIT_L(0); PG8_MMA(1, 0, At, B0); PG8_BAR; PG8_SCHED;
            PG8_STAGE(PG8_SB(1, 1), b3 + hstep, voffB);
            PG8_WAIT_V(6); PG8_BAR; PG8_MMA(1, 1, At, B1); PG8_BAR;
            }
        }
        if constexpr (ALIGN_EPI) { if (wr == 0) PG8_BAR; }
        if constexpr (!Epi::AFTER_DRAIN) { E(acc, cur, wr, wc, fr, fq); S.done(cur); }
        if (!has_next) break;
#pragma unroll
        for (int a = 0; a < 2; ++a)
#pragma unroll
            for (int b = 0; b < 2; ++b)
#pragma unroll
                for (int m = 0; m < 4; ++m)
#pragma unroll
                    for (int n = 0; n < 2; ++n) acc[a][b][m][n] = (f32x4){0.f, 0.f, 0.f, 0.f};
        cur = nxt; cA = nA; cB = nB; ++ui;
        if constexpr (ALIGN_EPI) { if (wr == 1) PG8_BAR; }
    }
    PG8_WAIT_V(0);
    if constexpr (!ALIGN_EPI) { if (wr == 0) PG8_BAR; }
    PG8_BAR;
    if constexpr (Epi::AFTER_DRAIN) { E.fused(acc, cur, wr, wc, fr, fq, lds, wid, lane); S.done(cur); }
#undef PG8_SA
#undef PG8_SB
#undef PG8_STAGE
#undef PG8_LDA
#undef PG8_LDB
#undef PG8_MMA
#undef PG8_WAIT_V
#undef PG8_WAIT_L
#undef PG8_BAR
#undef PG8_SCHED
}
}
#define LAS __attribute__((address_space(3)))
typedef unsigned short bf16_t;
typedef float f32x4 __attribute__((ext_vector_type(4)));
typedef unsigned u32x4 __attribute__((ext_vector_type(4)));
typedef unsigned u32x2 __attribute__((ext_vector_type(2)));

constexpr int DM = 1024, NB = 4, SEQ = 8192, CTXL = 256, NLAT = NB * SEQ, NCTX = NB * CTXL, MT = NLAT + NCTX;
constexpr int FF = 4096, ABIN = 2480, ABPAD = 2560;
constexpr int C_MQ = 0, C_MK = 512, C_MV = 1024, C_MO = 1536, C_MG = 2048, C_CQ = 2064, C_CKV = 2320, C_KR = 2448;
constexpr float EPS = 1e-6f;
constexpr size_t MiB = 1u << 20;
constexpr size_t WS_MOD = 1 * MiB;
constexpr size_t WS_XCTX = 2 * MiB;
constexpr size_t WS_WIN = 8 * MiB;
constexpr size_t WS_WUQ = 13 * MiB;
constexpr size_t WS_WUKV = 13 * MiB + 512 * 1024;
constexpr size_t WS_WOUT = 14 * MiB;
constexpr size_t WS_WNA = 16 * MiB;
constexpr size_t WS_WNAOUT = 22 * MiB;
constexpr size_t WS_W1 = 24 * MiB;
constexpr size_t WS_W2 = 40 * MiB;
constexpr size_t WS_XN = 56 * MiB;
constexpr size_t WS_Y = 122 * MiB;
constexpr size_t WS_XR = WS_Y;
constexpr size_t WS_CKVN = WS_Y;
constexpr size_t WS_BIG = 188 * MiB;
constexpr size_t WS_PROJ = WS_BIG;
constexpr size_t WS_QA = 353 * MiB;
constexpr size_t WS_KA = 403 * MiB;
constexpr size_t WS_VT = 453 * MiB;
constexpr size_t WS_CQN = 487 * MiB;
constexpr size_t WS_CKVN_UNUSED = 504 * MiB;
constexpr size_t WS_ST = 353 * MiB;
constexpr size_t WS_SC = 1 * MiB + 512 * 1024;
constexpr size_t WS_MS = WS_SC + 64 * 1024;
constexpr int ST_SLOT = 129 * 128;
constexpr size_t WS_BAR = 1 * MiB + 768 * 1024;
constexpr size_t WS_VT1 = 390 * MiB;
constexpr size_t WS_END = 504 * MiB;
static_assert(WS_ST + (size_t)2 * 16 * 132 * ST_SLOT * 2 <= 487 * MiB, "ST fits in the QA|KA|VT span");
constexpr int LDS_BYTES = 147456;

struct P { const float* in[22]; float* out; unsigned char* ws; int ph_lo, ph_hi; };
enum { I_X = 0, I_C, I_CTX, I_CCTX, I_ADAW, I_ADAB, I_N1G, I_N2G, I_W1, I_W2, I_ABWIN, I_GATEB, I_MNG, I_QNG, I_KVNG, I_WUQ, I_WUKV, I_ABWOUT, I_NAWIN, I_RELB, I_NAWOUT, I_FNG };

__device__ __forceinline__ float bf2f(unsigned h) { return __uint_as_float(h << 16); }
__device__ __forceinline__ float bflo(unsigned w) { return __uint_as_float(w << 16); }
__device__ __forceinline__ float bfhi(unsigned w) { return __uint_as_float(w & 0xffff0000u); }
__device__ __forceinline__ unsigned f2bf(float f) { unsigned u = __float_as_uint(f); return (u + 0x7fffu + ((u >> 16) & 1u)) >> 16; }
__device__ __forceinline__ unsigned pk2(float lo, float hi) { return f2bf(lo) | (f2bf(hi) << 16); }
__device__ __forceinline__ float wave_sum(float v) {
#pragma unroll
    for (int o = 1; o < 64; o <<= 1) v += __shfl_xor(v, o);
    return v;
}
#define LDS_WAIT() asm volatile("s_waitcnt lgkmcnt(0)" ::: "memory")

template <int ACT  > struct EpiBf16 {
    static constexpr bool PERM = true, AFTER_DRAIN = false;
    bf16_t* O; int ldc;
    __device__ __forceinline__ void operator()(const pg8::f32x4 (&acc)[2][2][4][2], const pg8::Unit& u, int wr, int wc, int fr, int fq) const {
        const int row0 = u.pm * 256 + wr * 64 + fr, col0 = u.pn * 256 + wc * 32 + 8 * fq;
#pragma unroll
        for (int ai = 0; ai < 2; ++ai)
#pragma unroll
            for (int m = 0; m < 4; ++m) { bf16_t* rowp = O + (size_t)(row0 + ai * 128 + m * 16) * ldc + col0;
#pragma unroll
                for (int bj = 0; bj < 2; ++bj) { pg8::f32x4 v0 = acc[ai][bj][m][0], v1 = acc[ai][bj][m][1];
                    if (ACT == 2) {
#pragma unroll
                        for (int e = 0; e < 4; ++e) { float a = fmaxf(v0[e], 0.f), b = fmaxf(v1[e], 0.f); v0[e] = a * a; v1[e] = b * b; } }
                    u32x4 w; w.x = pg8::cvt_pk_bf16(v0[0], v0[1]); w.y = pg8::cvt_pk_bf16(v0[2], v0[3]); w.z = pg8::cvt_pk_bf16(v1[0], v1[1]); w.w = pg8::cvt_pk_bf16(v1[2], v1[3]);
                    *(u32x4*)(rowp + bj * 128) = w; } }
    }
};
struct EpiRes {
    static constexpr bool PERM = true, AFTER_DRAIN = false;
    const float* in_lat; const float* in_ctx; float* out_lat; float* out_ctx; const float* gate;
    __device__ __forceinline__ void operator()(const pg8::f32x4 (&acc)[2][2][4][2], const pg8::Unit& u, int wr, int wc, int fr, int fq) const {
        const int row0 = u.pm * 256 + wr * 64 + fr, col0 = u.pn * 256 + wc * 32 + 8 * fq;
#pragma unroll
        for (int ai = 0; ai < 2; ++ai)
#pragma unroll
            for (int m = 0; m < 4; ++m) { const int row = row0 + ai * 128 + m * 16;
                const float* ip; float* op; int mr;
                if (row < NLAT) { ip = in_lat + (size_t)row * DM; op = out_lat + (size_t)row * DM; mr = row >> 13; }
                else { ip = in_ctx + (size_t)(row - NLAT) * DM; op = out_ctx + (size_t)(row - NLAT) * DM; mr = 4; }
                const float* gp = gate + mr * 6144;
#pragma unroll
                for (int bj = 0; bj < 2; ++bj) { const int c = col0 + bj * 128;
                    const f32x4 g0 = *(const f32x4*)(gp + c), g1 = *(const f32x4*)(gp + c + 4);
                    const f32x4 x0 = *(const f32x4*)(ip + c), x1 = *(const f32x4*)(ip + c + 4);
                    *(f32x4*)(op + c) = x0 + g0 * acc[ai][bj][m][0]; *(f32x4*)(op + c + 4) = x1 + g1 * acc[ai][bj][m][1]; } }
    }
};

struct EpiRes16 {
    static constexpr bool PERM = true, AFTER_DRAIN = false;
    const float* in32; bf16_t* xr; const float* gate;
    __device__ __forceinline__ void operator()(const pg8::f32x4 (&acc)[2][2][4][2], const pg8::Unit& u, int wr, int wc, int fr, int fq) const {
        const int row0 = u.pm * 256 + wr * 64 + fr, col0 = u.pn * 256 + wc * 32 + 8 * fq;
#pragma unroll
        for (int ai = 0; ai < 2; ++ai)
#pragma unroll
            for (int m = 0; m < 4; ++m) { const int row = row0 + ai * 128 + m * 16; const float* gp = gate + (row >> 13) * 6144; bf16_t* xp = xr + (size_t)row * DM;
#pragma unroll
                for (int bj = 0; bj < 2; ++bj) { const int c = col0 + bj * 128;
                    f32x4 x0, x1;
                    if (in32) { x0 = *(const f32x4*)(in32 + (size_t)row * DM + c); x1 = *(const f32x4*)(in32 + (size_t)row * DM + c + 4); }
                    else { const u32x4 w = *(const u32x4*)(xp + c); x0 = (f32x4){bflo(w.x), bfhi(w.x), bflo(w.y), bfhi(w.y)}; x1 = (f32x4){bflo(w.z), bfhi(w.z), bflo(w.w), bfhi(w.w)}; }
                    const f32x4 v0 = x0 + *(const f32x4*)(gp + c) * acc[ai][bj][m][0], v1 = x1 + *(const f32x4*)(gp + c + 4) * acc[ai][bj][m][1];
                    u32x4 o; o.x = pk2(v0.x, v0.y); o.y = pk2(v0.z, v0.w); o.z = pk2(v1.x, v1.y); o.w = pk2(v1.z, v1.w);
                    *(u32x4*)(xp + c) = o; } }
    }
};
__device__ __forceinline__ void transpose_item(const float* W, int K, int N, int Npad, bf16_t* WT, LAS float* scr, int item, int lane) {
    const int nblk = Npad / 32, kb = item / nblk, nb = item % nblk, k0 = 64 * kb, n0 = 32 * nb;
    const int kr = lane >> 3, n4 = 4 * (lane & 7); const bool inb = (n0 + n4) < N;
    f32x4 tv[8];
#pragma unroll
    for (int i = 0; i < 8; ++i) tv[i] = inb ? *(const f32x4*)(W + (size_t)(k0 + 8 * i + kr) * N + n0 + n4) : (f32x4){0.f, 0.f, 0.f, 0.f};
#pragma unroll
    for (int i = 0; i < 8; ++i) { LAS float* d = scr + (8 * i + kr) * 33 + n4; d[0] = tv[i].x; d[1] = tv[i].y; d[2] = tv[i].z; d[3] = tv[i].w; }
    LDS_WAIT(); asm volatile("" ::: "memory");
    const int c = lane & 7;
#pragma unroll
    for (int j = 0; j < 4; ++j) { const int nn = (lane >> 3) + 8 * j; const LAS float* s = scr + (8 * c) * 33 + nn;
        u32x4 o; o.x = pk2(s[0 * 33], s[1 * 33]); o.y = pk2(s[2 * 33], s[3 * 33]); o.z = pk2(s[4 * 33], s[5 * 33]); o.w = pk2(s[6 * 33], s[7 * 33]);
        *(u32x4*)(WT + (size_t)(n0 + nn) * K + k0 + 8 * c) = o; }
    LDS_WAIT(); asm volatile("" ::: "memory");
}
__device__ __forceinline__ void p0_phase(const P& p, LAS unsigned char* lds, int bid, int G, int tid, int wave, int lane) {
    {
        LAS float* sil = (LAS float*)lds;
        LAS float* red = sil + 5 * 1024;
        if (bid < 192) {
            for (int i = tid; i < 5 * 1024; i += 512) { const int r = i >> 10, k = i & 1023; const float x = (r < 4) ? p.in[I_C][r * 1024 + k] : p.in[I_CCTX][k]; sil[i] = x / (1.f + expf(-x)); }
            __syncthreads();
            for (int it = bid; it < 192; it += G) {
                const int l = it / 96, cb = it % 96, col = cb * 64 + lane;
                const float* w = p.in[I_ADAW] + (size_t)l * 1024 * 6144 + col;
                float a0 = 0.f, a1 = 0.f, a2 = 0.f, a3 = 0.f, a4 = 0.f;
#pragma unroll 32
                for (int k = wave * 128; k < wave * 128 + 128; ++k) { const float ww = w[(size_t)k * 6144];
                    a0 += sil[k] * ww; a1 += sil[1024 + k] * ww; a2 += sil[2048 + k] * ww; a3 += sil[3072 + k] * ww; a4 += sil[4096 + k] * ww; }
                red[(wave * 5 + 0) * 64 + lane] = a0; red[(wave * 5 + 1) * 64 + lane] = a1; red[(wave * 5 + 2) * 64 + lane] = a2; red[(wave * 5 + 3) * 64 + lane] = a3; red[(wave * 5 + 4) * 64 + lane] = a4;
                __syncthreads();
                if (tid < 320) { const int r = tid >> 6, cl = tid & 63; float s = p.in[I_ADAB][l * 6144 + cb * 64 + cl];
#pragma unroll
                    for (int wv = 0; wv < 8; ++wv) s += red[(wv * 5 + r) * 64 + cl];
                    ((float*)(p.ws + WS_MOD))[(l * 5 + r) * 6144 + cb * 64 + cl] = s; }
                __syncthreads();
            }
        }
        __syncthreads();
    }
    {
        LAS float* scr = (LAS float*)(lds + wave * 16384);
        const int gw = bid * 8 + wave, NGW = G * 8;
        constexpr int I0 = 16 * 80, I1 = 4 * 24, I2 = 2 * 32, I3 = 16 * 32, I4 = 16 * 96, I5 = 16 * 32, I6 = 16 * 128, I8 = 64 * 32;
        constexpr int NIT = I0 + I1 + I2 + I3 + I4 + I5 + 2 * I6 + 2 * I8;
        for (int it = gw; it < NIT; it += NGW) {
            int r = it;
            if (r < I0) { transpose_item(p.in[I_ABWIN], 1024, ABIN, ABPAD, (bf16_t*)(p.ws + WS_WIN), scr, r, lane); continue; } r -= I0;
            if (r < I1) { transpose_item(p.in[I_WUQ], 256, 768, 768, (bf16_t*)(p.ws + WS_WUQ), scr, r, lane); continue; } r -= I1;
            if (r < I2) { transpose_item(p.in[I_WUKV], 128, 1024, 1024, (bf16_t*)(p.ws + WS_WUKV), scr, r, lane); continue; } r -= I2;
            if (r < I3) { transpose_item(p.in[I_ABWOUT], 1024, 1024, 1024, (bf16_t*)(p.ws + WS_WOUT), scr, r, lane); continue; } r -= I3;
            if (r < I4) { transpose_item(p.in[I_NAWIN], 1024, 3072, 3072, (bf16_t*)(p.ws + WS_WNA), scr, r, lane); continue; } r -= I4;
            if (r < I5) { transpose_item(p.in[I_NAWOUT], 1024, 1024, 1024, (bf16_t*)(p.ws + WS_WNAOUT), scr, r, lane); continue; } r -= I5;
            if (r < 2 * I6) { const int l = r / I6; transpose_item(p.in[I_W1] + (size_t)l * 1024 * 4096, 1024, 4096, 4096, (bf16_t*)(p.ws + WS_W1) + (size_t)l * 4096 * 1024, scr, r % I6, lane); continue; } r -= 2 * I6;
            { const int l = r / I8; transpose_item(p.in[I_W2] + (size_t)l * 4096 * 1024, 4096, 1024, 1024, (bf16_t*)(p.ws + WS_W2) + (size_t)l * 1024 * 4096, scr, r % I8, lane); }
        }
    }
}

__device__ __forceinline__ void modulate_phase(const float* src_lat, const float* src_ctx, int nrows, const float* g, const float* modl, int off_sh, int off_sc, bf16_t* XN, int gw, int NGW, int lane,
                                               const float* part = nullptr, int ns = 0, const float* pgate = nullptr, float* xback = nullptr, const bf16_t* src_lat16 = nullptr) {
    for (int row0 = gw; row0 < nrows; row0 += 2 * NGW) {
        f32x4 v[2][4]; float s[2] = {0.f, 0.f};
#pragma unroll
        for (int r = 0; r < 2; ++r) { const int row = min(row0 + r * NGW, nrows - 1);
            if (src_lat16 && row < NLAT) { const u32x2* x16 = (const u32x2*)(src_lat16 + (size_t)row * DM) + lane;
#pragma unroll
                for (int j = 0; j < 4; ++j) { const u32x2 w = __builtin_nontemporal_load(x16 + 64 * j); v[r][j] = (f32x4){bflo(w.x), bfhi(w.x), bflo(w.y), bfhi(w.y)}; } }
            else { const float* src = (row < NLAT) ? src_lat + (size_t)row * DM : src_ctx + (size_t)(row - NLAT) * DM; const f32x4* xr = (const f32x4*)src + lane;
#pragma unroll
                for (int j = 0; j < 4; ++j) v[r][j] = __builtin_nontemporal_load(xr + 64 * j); } }
#pragma unroll
        for (int r = 0; r < 2; ++r) { const int row = row0 + r * NGW;
            if (part && row >= NLAT && row < nrows) {
                const f32x4* pr = (const f32x4*)(part + (size_t)(row - NLAT) * DM) + lane; const f32x4* pg = (const f32x4*)pgate + lane;
#pragma unroll
                for (int j = 0; j < 4; ++j) { f32x4 a = pr[64 * j];
                    for (int q = 1; q < ns; ++q) a += pr[(size_t)q * (NCTX * DM / 4) + 64 * j];
                    v[r][j] += pg[64 * j] * a; }
                if (xback) { f32x4* xb = (f32x4*)(xback + (size_t)(row - NLAT) * DM) + lane;
#pragma unroll
                    for (int j = 0; j < 4; ++j) xb[64 * j] = v[r][j]; }
            }
#pragma unroll
            for (int j = 0; j < 4; ++j) s[r] += (v[r][j].x * v[r][j].x + v[r][j].y * v[r][j].y) + (v[r][j].z * v[r][j].z + v[r][j].w * v[r][j].w); }
        const float rs0 = rsqrtf(wave_sum(s[0]) * (1.f / DM) + EPS), rs1 = rsqrtf(wave_sum(s[1]) * (1.f / DM) + EPS);
#pragma unroll
        for (int r = 0; r < 2; ++r) { const int row = row0 + r * NGW;
            if (row < nrows) { const int mr = (row < NLAT) ? (row >> 13) : 4; const float rstd = r ? rs1 : rs0;
                const f32x4* g4 = (const f32x4*)g + lane; const f32x4* sh4 = (const f32x4*)(modl + mr * 6144 + off_sh) + lane; const f32x4* sc4 = (const f32x4*)(modl + mr * 6144 + off_sc) + lane;
                u32x2* o8 = (u32x2*)(XN + (size_t)row * DM) + lane;
#pragma unroll
                for (int j = 0; j < 4; ++j) { const f32x4 gg = g4[64 * j], sh = sh4[64 * j], sc = sc4[64 * j];
                    const f32x4 y = (v[r][j] * rstd * gg) * (sc + 1.f) + sh; u32x2 w; w.x = pk2(y.x, y.y); w.y = pk2(y.z, y.w); o8[64 * j] = w; } } }
    }
}

__device__ __forceinline__ float rope_angle(int t, int j) {
    const float pos = (j < 8) ? (float)(t >> 6) : (float)(t & 63);
    const float fr = powf(10000.0f, -(float)(j & 7) / 8.0f);
    return pos * fr;
}

__device__ __forceinline__ float sum16(float v) { v += __shfl_xor(v, 1); v += __shfl_xor(v, 2); v += __shfl_xor(v, 4); v += __shfl_xor(v, 8); return v; }
__device__ __forceinline__ void p3a_phase(const P& p, int gw, int NGW, int lane) {
    const bf16_t* PROJ = (const bf16_t*)(p.ws + WS_PROJ);
    bf16_t* CQN = (bf16_t*)(p.ws + WS_CQN); bf16_t* CKVN = (bf16_t*)(p.ws + WS_CKVN); bf16_t* KA = (bf16_t*)(p.ws + WS_KA);
    const int l16 = lane & 15, sub = lane >> 4;
    f32x4 gq[4]; f32x4 gk[2];
#pragma unroll
    for (int i = 0; i < 4; ++i) gq[i] = *((const f32x4*)p.in[I_QNG] + 4 * l16 + i);
#pragma unroll
    for (int i = 0; i < 2; ++i) gk[i] = *((const f32x4*)p.in[I_KVNG] + 2 * l16 + i);
    for (int rg = gw; rg < MT / 4; rg += NGW) {
        const int row = 4 * rg + sub;
        const bf16_t* pr = PROJ + (size_t)row * ABPAD;
        { const u32x4 w0 = *(const u32x4*)(pr + C_CQ + 16 * l16), w1 = *(const u32x4*)(pr + C_CQ + 16 * l16 + 8);
          float v[16] = {bflo(w0.x), bfhi(w0.x), bflo(w0.y), bfhi(w0.y), bflo(w0.z), bfhi(w0.z), bflo(w0.w), bfhi(w0.w), bflo(w1.x), bfhi(w1.x), bflo(w1.y), bfhi(w1.y), bflo(w1.z), bfhi(w1.z), bflo(w1.w), bfhi(w1.w)};
          float ss = 0.f;
#pragma unroll
          for (int i = 0; i < 16; ++i) ss += v[i] * v[i];
          const float rstd = rsqrtf(sum16(ss) * (1.f / 256.f) + EPS);
          u32x4 o0, o1;
          o0.x = pk2(v[0] * rstd * gq[0].x, v[1] * rstd * gq[0].y); o0.y = pk2(v[2] * rstd * gq[0].z, v[3] * rstd * gq[0].w); o0.z = pk2(v[4] * rstd * gq[1].x, v[5] * rstd * gq[1].y); o0.w = pk2(v[6] * rstd * gq[1].z, v[7] * rstd * gq[1].w);
          o1.x = pk2(v[8] * rstd * gq[2].x, v[9] * rstd * gq[2].y); o1.y = pk2(v[10] * rstd * gq[2].z, v[11] * rstd * gq[2].w); o1.z = pk2(v[12] * rstd * gq[3].x, v[13] * rstd * gq[3].y); o1.w = pk2(v[14] * rstd * gq[3].z, v[15] * rstd * gq[3].w);
          *(u32x4*)(CQN + (size_t)row * 256 + 16 * l16) = o0; *(u32x4*)(CQN + (size_t)row * 256 + 16 * l16 + 8) = o1; }
        { const u32x4 w = *(const u32x4*)(pr + C_CKV + 8 * l16);
          float v[8] = {bflo(w.x), bfhi(w.x), bflo(w.y), bfhi(w.y), bflo(w.z), bfhi(w.z), bflo(w.w), bfhi(w.w)};
          float ss = 0.f;
#pragma unroll
          for (int i = 0; i < 8; ++i) ss += v[i] * v[i];
          const float rstd = rsqrtf(sum16(ss) * (1.f / 128.f) + EPS);
          u32x4 o; o.x = pk2(v[0] * rstd * gk[0].x, v[1] * rstd * gk[0].y); o.y = pk2(v[2] * rstd * gk[0].z, v[3] * rstd * gk[0].w); o.z = pk2(v[4] * rstd * gk[1].x, v[5] * rstd * gk[1].y); o.w = pk2(v[6] * rstd * gk[1].z, v[7] * rstd * gk[1].w);
          *(u32x4*)(CKVN + (size_t)row * 128 + 8 * l16) = o; }
        { float xa = bf2f(pr[C_KR + l16]), xb = bf2f(pr[C_KR + 16 + l16]);
          if (row < NLAT) { const float ang = rope_angle(row & 8191, l16); const float cs = cosf(ang), sn = sinf(ang); const float ya = xa * cs - xb * sn, yb = xa * sn + xb * cs; xa = ya; xb = yb; }
          const bf16_t ba = (bf16_t)f2bf(xa), bb = (bf16_t)f2bf(xb);
#pragma unroll
          for (int hh = 0; hh < 8; ++hh) { KA[(size_t)row * 768 + hh * 96 + 64 + l16] = ba; KA[(size_t)row * 768 + hh * 96 + 80 + l16] = bb; } }
    }
}

__device__ __forceinline__ float dot8(const u32x4 w, const float* q) {
    return (q[0] * bflo(w.x) + q[1] * bfhi(w.x)) + (q[2] * bflo(w.y) + q[3] * bfhi(w.y)) + (q[4] * bflo(w.z) + q[5] * bfhi(w.z)) + (q[6] * bflo(w.w) + q[7] * bfhi(w.w));
}
__device__ __forceinline__ void axpy8(float* o, float pw, const u32x4 w) {
    o[0] += pw * bflo(w.x); o[1] += pw * bfhi(w.x); o[2] += pw * bflo(w.y); o[3] += pw * bfhi(w.y); o[4] += pw * bflo(w.z); o[5] += pw * bfhi(w.z); o[6] += pw * bflo(w.w); o[7] += pw * bfhi(w.w);
}

struct EpiKV {
    static constexpr bool PERM = true, AFTER_DRAIN = false;
    bf16_t* KA; bf16_t* VT;
    __device__ __forceinline__ void operator()(const pg8::f32x4 (&acc)[2][2][4][2], const pg8::Unit& u, int wr, int wc, int fr, int fq) const {
        const int row0 = u.pm * 256 + wr * 64 + fr;
        const int j0 = wc * 32 + 8 * fq;
#pragma unroll
        for (int ai = 0; ai < 2; ++ai)
#pragma unroll
            for (int m = 0; m < 4; ++m) { const int row = row0 + ai * 128 + m * 16;
                int b, key; if (row < NLAT) { b = row >> 13; key = row & 8191; } else { b = (row - NLAT) >> 8; key = SEQ + ((row - NLAT) & 255); }
                { const int q4 = (key >> 2) & 3; key = (key & ~12) | ((((q4 & 1) << 1) | (q4 >> 1)) << 2); }
#pragma unroll
                for (int bj = 0; bj < 2; ++bj) { const int head = u.pn * 2 + bj; const pg8::f32x4 v0 = acc[ai][bj][m][0], v1 = acc[ai][bj][m][1];
                    if (j0 < 64) { u32x4 w; w.x = pk2(v0[0], v0[1]); w.y = pk2(v0[2], v0[3]); w.z = pk2(v1[0], v1[1]); w.w = pk2(v1[2], v1[3]);
                        *(u32x4*)(KA + (size_t)row * 768 + head * 96 + j0) = w; }
                    else { bf16_t* vp = VT + ((size_t)(b * 8 + head) * 64 + (j0 - 64)) * 8448 + key;
#pragma unroll
                        for (int e = 0; e < 4; ++e) { vp[(size_t)e * 8448] = (bf16_t)f2bf(v0[e]); vp[(size_t)(e + 4) * 8448] = (bf16_t)f2bf(v1[e]); } } } }
    }
};

typedef float f32x16 __attribute__((ext_vector_type(16)));
typedef short bf16x8 __attribute__((ext_vector_type(8)));
typedef float f32x2_t __attribute__((ext_vector_type(2)));
typedef __bf16 bf16x2_t __attribute__((ext_vector_type(2)));
__device__ __forceinline__ unsigned cvtpk(float lo, float hi) { f32x2_t v = {lo, hi}; bf16x2_t b = __builtin_convertvector(v, bf16x2_t); return __builtin_bit_cast(unsigned, b); }
__device__ __forceinline__ float xhalf_max(float v) { auto rr = __builtin_amdgcn_permlane32_swap(__float_as_uint(v), __float_as_uint(v), false, false); return fmaxf(__uint_as_float(rr[0]), __uint_as_float(rr[1])); }
__device__ __forceinline__ float xhalf_sum(float v) { auto rr = __builtin_amdgcn_permlane32_swap(__float_as_uint(v), __float_as_uint(v), false, false); return __uint_as_float(rr[0]) + __uint_as_float(rr[1]); }
constexpr int MLA_KP = 208, MLA_VP = 144, MLA_KB = 64 * MLA_KP, MLA_VB = 64 * MLA_VP, MLA_BUF = MLA_KB + MLA_VB;
__device__ __forceinline__ int mla_tile_row0(int b, int kt) { return kt < 128 ? b * SEQ + 64 * kt : NLAT + b * CTXL + 64 * (kt - 128); }
template <int MF> __device__ __forceinline__ void mla_attn_phase(const P& p, LAS unsigned char* lds, int bid, int G, int tid, int wave, int lane) {
    const bf16_t* QA = (const bf16_t*)(p.ws + WS_QA); const bf16_t* KA = (const bf16_t*)(p.ws + WS_KA); const bf16_t* VT = (const bf16_t*)(p.ws + WS_VT);
    bf16_t* Y = MF ? (bf16_t*)(p.ws + WS_XN) : (bf16_t*)p.out;
    const int vcu = (G % 8 == 0) ? (bid % 8) * (G / 8) + bid / 8 : bid;
    const int r32 = lane & 31, hi = lane >> 5;
    const int kr0 = tid / 12, kc0 = tid % 12, kr1 = (tid + 512) / 12, kc1 = (tid + 512) % 12, vd = tid >> 3, vc = tid & 7;
    for (int u = vcu; u < 1056; u += G) {
        int b, h, qrow0, kt0; const int kt1 = 132;
        if (u < 1024) { const int bh = u >> 5; b = bh >> 3; h = bh & 7; qrow0 = b * SEQ + (u & 31) * 256; kt0 = 0; }
        else { const int bh = u - 1024; b = bh >> 3; h = bh & 7; qrow0 = NLAT + b * CTXL; kt0 = 128; }
        const int qrow = qrow0 + wave * 32 + r32;
        bf16x8 qf[6];
        { float qv[6][8];
#pragma unroll
          for (int ks = 0; ks < 6; ++ks) { const u32x4 w = *(const u32x4*)(QA + (size_t)qrow * 768 + h * 96 + 16 * ks + 8 * hi);
              qv[ks][0] = bflo(w.x); qv[ks][1] = bfhi(w.x); qv[ks][2] = bflo(w.y); qv[ks][3] = bfhi(w.y); qv[ks][4] = bflo(w.z); qv[ks][5] = bfhi(w.z); qv[ks][6] = bflo(w.w); qv[ks][7] = bfhi(w.w); }
          if (u < 1024) { const int t = qrow & 8191;
#pragma unroll
              for (int j = 0; j < 8; ++j) { const float ang = rope_angle(t, 8 * hi + j); const float cs = cosf(ang), sn = sinf(ang);
                  const float xa = qv[4][j], xb = qv[5][j]; qv[4][j] = xa * cs - xb * sn; qv[5][j] = xa * sn + xb * cs; } }
          const float sc = 0.10206207261596577f * 1.4426950408889634f;
#pragma unroll
          for (int ks = 0; ks < 6; ++ks) { u32x4 w; w.x = pk2(qv[ks][0] * sc, qv[ks][1] * sc); w.y = pk2(qv[ks][2] * sc, qv[ks][3] * sc); w.z = pk2(qv[ks][4] * sc, qv[ks][5] * sc); w.w = pk2(qv[ks][6] * sc, qv[ks][7] * sc);
              qf[ks] = __builtin_bit_cast(bf16x8, w); } }
        const bf16_t* VTh = VT + (size_t)(b * 8 + h) * 64 * 8448;
        const int pc1 = wave + 8, pc2 = min(wave + 16, 21);
        size_t dsrc0, dsrc1, dsrc2; bool v1;
        { const int s0_ = 64 * wave + lane; dsrc0 = (size_t)(s0_ / 13) * 768 + h * 96 + min(s0_ % 13, 11) * 8;
          v1 = pc1 >= 13;
          if (!v1) { const int s1_ = 64 * pc1 + lane; dsrc1 = (size_t)(s1_ / 13) * 768 + h * 96 + min(s1_ % 13, 11) * 8; }
          else { const int s1_ = 64 * (pc1 - 13) + lane; dsrc1 = (size_t)(s1_ / 9) * 8448 + min(s1_ % 9, 7) * 8; }
          const int s2_ = 64 * (pc2 - 13) + lane; dsrc2 = (size_t)(s2_ / 9) * 8448 + min(s2_ % 9, 7) * 8; }
#define MLA_DMA(ST, KTL) do { const int ktl_ = (KTL); const bf16_t* kb_ = KA + (size_t)mla_tile_row0(b, ktl_) * 768; const bf16_t* vb_ = VTh + 64 * ktl_; LAS unsigned char* sb_ = lds + (ST) * MLA_BUF; \
            __builtin_amdgcn_global_load_lds((const unsigned*)(kb_ + dsrc0), (LAS unsigned*)(sb_ + wave * 1024), 16, 0, 0); \
            __builtin_amdgcn_global_load_lds((const unsigned*)((v1 ? vb_ : kb_) + dsrc1), (LAS unsigned*)(sb_ + pc1 * 1024), 16, 0, 0); \
            __builtin_amdgcn_global_load_lds((const unsigned*)(vb_ + dsrc2), (LAS unsigned*)(sb_ + pc2 * 1024), 16, 0, 0); } while (0)
        MLA_DMA(0, kt0); MLA_DMA(1, min(kt0 + 1, kt1 - 1)); MLA_DMA(2, min(kt0 + 2, kt1 - 1));
        asm volatile("s_waitcnt vmcnt(3)\n\ts_barrier" ::: "memory");
        f32x16 o0, o1, cA0, cA1, cB0, cB1; const f32x16 z16 = {0.f, 0.f, 0.f, 0.f, 0.f, 0.f, 0.f, 0.f, 0.f, 0.f, 0.f, 0.f, 0.f, 0.f, 0.f, 0.f};
#pragma unroll
        for (int i = 0; i < 16; ++i) { o0[i] = 0.f; o1[i] = 0.f; }
#define MLA_MFMA(a, bq, c) __builtin_amdgcn_mfma_f32_32x32x16_bf16((a), (bq), (c), 0, 0, 0)
#define MLA_QK(P0, P1, ST) do { const LAS unsigned char* Kb_ = lds + (ST) * MLA_BUF + r32 * MLA_KP + hi * 16; \
            _Pragma("unroll") for (int ks = 0; ks < 6; ++ks) { const bf16x8 k0_ = *(const LAS bf16x8*)(Kb_ + ks * 32); const bf16x8 k1_ = *(const LAS bf16x8*)(Kb_ + 32 * MLA_KP + ks * 32); \
                if (ks == 0) { P0 = MLA_MFMA(k0_, qf[0], z16); P1 = MLA_MFMA(k1_, qf[0], z16); } else { P0 = MLA_MFMA(k0_, qf[ks], P0); P1 = MLA_MFMA(k1_, qf[ks], P1); } } } while (0)
        float m, l = 0.f;
        { MLA_QK(cA0, cA1, 0);
          float rm = fmaxf(cA0[0], cA1[0]);
#pragma unroll
          for (int i = 1; i < 16; ++i) rm = fmaxf(rm, fmaxf(cA0[i], cA1[i]));
          rm = xhalf_max(rm); m = (fabsf(rm) > 16.f) ? rm : 0.f;
          if (__any(m != 0.f)) {
#pragma unroll
              for (int i = 0; i < 16; ++i) { cA0[i] -= m; cA1[i] -= m; } } }
        int s_cur = 0, s_nxt = 1, s_lnd = 2, s_pre = 3;
#define MLA_STEP(C0, C1, N0, N1, KT) do { const int kt_ = (KT); \
            MLA_DMA(s_pre, min(kt_ + 3, kt1 - 1)); \
            if (!(MF & 4)) MLA_QK(N0, N1, s_nxt); \
            float ls = 0.f; \
            if (!(MF & 1)) { _Pragma("unroll") for (int i = 0; i < 16; ++i) { C0[i] = __builtin_amdgcn_exp2f(C0[i]); C1[i] = __builtin_amdgcn_exp2f(C1[i]); ls += C0[i] + C1[i]; } } else ls = 1.f; \
            const LAS unsigned char* Vb = lds + s_cur * MLA_BUF + MLA_KB; \
            if (!(MF & 2)) _Pragma("unroll") for (int kh = 0; kh < 2; ++kh) \
            _Pragma("unroll") for (int s2 = 0; s2 < 2; ++s2) { const int kb = (32 * kh + 16 * s2 + 8 * hi) * 2; \
                u32x4 w; if (kh == 0) { w.x = cvtpk(C0[8 * s2], C0[8 * s2 + 1]); w.y = cvtpk(C0[8 * s2 + 2], C0[8 * s2 + 3]); w.z = cvtpk(C0[8 * s2 + 4], C0[8 * s2 + 5]); w.w = cvtpk(C0[8 * s2 + 6], C0[8 * s2 + 7]); } \
                else { w.x = cvtpk(C1[8 * s2], C1[8 * s2 + 1]); w.y = cvtpk(C1[8 * s2 + 2], C1[8 * s2 + 3]); w.z = cvtpk(C1[8 * s2 + 4], C1[8 * s2 + 5]); w.w = cvtpk(C1[8 * s2 + 6], C1[8 * s2 + 7]); } \
                const bf16x8 pf_ = __builtin_bit_cast(bf16x8, w); \
                const bf16x8 va_ = *(const LAS bf16x8*)(Vb + r32 * MLA_VP + kb), vb_ = *(const LAS bf16x8*)(Vb + (32 + r32) * MLA_VP + kb); \
                o0 = MLA_MFMA(va_, pf_, o0); o1 = MLA_MFMA(vb_, pf_, o1); } \
            l += ls; const float lsx = xhalf_sum(ls); \
            asm volatile("s_waitcnt vmcnt(3) lgkmcnt(0)\n\ts_barrier" ::: "memory");       \
            { const int t_ = s_cur; s_cur = s_nxt; s_nxt = s_lnd; s_lnd = s_pre; s_pre = t_; } \
            if (__any((lsx > 65536.f) || (m != 0.f))) { const float dl = (lsx > 65536.f) ? __log2f(lsx) : 0.f; const float al = __builtin_amdgcn_exp2f(-dl); m += dl; l *= al; \
                _Pragma("unroll") for (int i = 0; i < 16; ++i) { o0[i] *= al; o1[i] *= al; N0[i] -= m; N1[i] -= m; } } \
            } while (0)
        for (int kt = kt0; kt < kt1; kt += 2) { MLA_STEP(cA0, cA1, cB0, cB1, kt); MLA_STEP(cB0, cB1, cA0, cA1, kt + 1); }
        __syncthreads();
#undef MLA_STEP
#undef MLA_DMA
#undef MLA_QK
#undef MLA_MFMA
        const float il = 1.f / xhalf_sum(l);
        bf16_t* yp = Y + (size_t)qrow * 1024 + 512 + h * 64 + 4 * hi;
#pragma unroll
        for (int g = 0; g < 4; ++g) { u32x2 w; w.x = pk2(o0[4 * g] * il, o0[4 * g + 1] * il); w.y = pk2(o0[4 * g + 2] * il, o0[4 * g + 3] * il); *(u32x2*)(yp + 8 * g) = w;
            u32x2 x; x.x = pk2(o1[4 * g] * il, o1[4 * g + 1] * il); x.y = pk2(o1[4 * g + 2] * il, o1[4 * g + 3] * il); *(u32x2*)(yp + 32 + 8 * g) = x; }
    }
}

__device__ __forceinline__ void mla_attn_w64(const P& p, LAS unsigned char* lds, int bid, int G, int tid, int wave, int lane) {
    const bf16_t* QA = (const bf16_t*)(p.ws + WS_QA); const bf16_t* KA = (const bf16_t*)(p.ws + WS_KA); const bf16_t* VT = (const bf16_t*)(p.ws + WS_VT);
    bf16_t* Y = (bf16_t*)p.out;
    const int vcu = (G % 8 == 0) ? (bid % 8) * (G / 8) + bid / 8 : bid;
    const int r32 = lane & 31, hi = lane >> 5;
#define W64_MFMA(a, bq, c) __builtin_amdgcn_mfma_f32_32x32x16_bf16((a), (bq), (c), 0, 0, 0)
    for (int u = vcu; u < 512 + 32; u += G) {
        int b, h, qrow0, kt0, rmask; const int kt1 = 132;
        if (u < 512) { const int bh = u >> 4; b = bh >> 3; h = bh & 7; qrow0 = b * SEQ + (u & 15) * 512; kt0 = 0; rmask = 511; }
        else { const int bh = u - 512; b = bh >> 3; h = bh & 7; qrow0 = NLAT + b * CTXL; kt0 = 128; rmask = 255; }
        const int qrowA = qrow0 + ((wave * 64 + r32) & rmask), qrowB = qrow0 + ((wave * 64 + 32 + r32) & rmask);
        bf16x8 qfA[6], qfB[6];
#pragma unroll
        for (int tl = 0; tl < 2; ++tl) { const int qrow = tl ? qrowB : qrowA; float qv[6][8];
#pragma unroll
          for (int ks = 0; ks < 6; ++ks) { const u32x4 w = *(const u32x4*)(QA + (size_t)qrow * 768 + h * 96 + 16 * ks + 8 * hi);
              qv[ks][0] = bflo(w.x); qv[ks][1] = bfhi(w.x); qv[ks][2] = bflo(w.y); qv[ks][3] = bfhi(w.y); qv[ks][4] = bflo(w.z); qv[ks][5] = bfhi(w.z); qv[ks][6] = bflo(w.w); qv[ks][7] = bfhi(w.w); }
          if (u < 512) { const int t = qrow & 8191;
#pragma unroll
              for (int j = 0; j < 8; ++j) { const float ang = rope_angle(t, 8 * hi + j); const float cs = cosf(ang), sn = sinf(ang);
                  const float xa = qv[4][j], xb = qv[5][j]; qv[4][j] = xa * cs - xb * sn; qv[5][j] = xa * sn + xb * cs; } }
          const float sc = 0.10206207261596577f * 1.4426950408889634f;
#pragma unroll
          for (int ks = 0; ks < 6; ++ks) { u32x4 w; w.x = pk2(qv[ks][0] * sc, qv[ks][1] * sc); w.y = pk2(qv[ks][2] * sc, qv[ks][3] * sc); w.z = pk2(qv[ks][4] * sc, qv[ks][5] * sc); w.w = pk2(qv[ks][6] * sc, qv[ks][7] * sc);
              if (tl) qfB[ks] = __builtin_bit_cast(bf16x8, w); else qfA[ks] = __builtin_bit_cast(bf16x8, w); } }
        const bf16_t* VTh = VT + (size_t)(b * 8 + h) * 64 * 8448;
        const int pc1 = wave + 8, pc2 = min(wave + 16, 21);
        size_t dsrc0, dsrc1, dsrc2; bool v1;
        { const int s0_ = 64 * wave + lane; dsrc0 = (size_t)(s0_ / 13) * 768 + h * 96 + min(s0_ % 13, 11) * 8;
          v1 = pc1 >= 13;
          if (!v1) { const int s1_ = 64 * pc1 + lane; dsrc1 = (size_t)(s1_ / 13) * 768 + h * 96 + min(s1_ % 13, 11) * 8; }
          else { const int s1_ = 64 * (pc1 - 13) + lane; dsrc1 = (size_t)(s1_ / 9) * 8448 + min(s1_ % 9, 7) * 8; }
          const int s2_ = 64 * (pc2 - 13) + lane; dsrc2 = (size_t)(s2_ / 9) * 8448 + min(s2_ % 9, 7) * 8; }
#define W64_DMA(ST, KTL) do { const int ktl_ = (KTL); const bf16_t* kb_ = KA + (size_t)mla_tile_row0(b, ktl_) * 768; const bf16_t* vb_ = VTh + 64 * ktl_; LAS unsigned char* sb_ = lds + (ST) * MLA_BUF; \
            __builtin_amdgcn_global_load_lds((const unsigned*)(kb_ + dsrc0), (LAS unsigned*)(sb_ + wave * 1024), 16, 0, 0); \
            __builtin_amdgcn_global_load_lds((const unsigned*)((v1 ? vb_ : kb_) + dsrc1), (LAS unsigned*)(sb_ + pc1 * 1024), 16, 0, 0); \
            __builtin_amdgcn_global_load_lds((const unsigned*)(vb_ + dsrc2), (LAS unsigned*)(sb_ + pc2 * 1024), 16, 0, 0); } while (0)
        W64_DMA(0, kt0); W64_DMA(1, min(kt0 + 1, kt1 - 1));
        asm volatile("s_waitcnt vmcnt(3)\n\ts_barrier" ::: "memory");
        f32x16 oA0, oA1, oB0, oB1; const f32x16 z16 = {0.f, 0.f, 0.f, 0.f, 0.f, 0.f, 0.f, 0.f, 0.f, 0.f, 0.f, 0.f, 0.f, 0.f, 0.f, 0.f};
#pragma unroll
        for (int i = 0; i < 16; ++i) { oA0[i] = 0.f; oA1[i] = 0.f; oB0[i] = 0.f; oB1[i] = 0.f; }
        float mA = 0.f, mB = 0.f, lA = 0.f, lB = 0.f;
        int s_cur = 0, s_nxt = 1, s_pre = 2;
        for (int kt = kt0; kt < kt1; ++kt) {
            W64_DMA(s_pre, min(kt + 2, kt1 - 1));
            const LAS unsigned char* Vb_ = lds + s_cur * MLA_BUF + MLA_KB;
#pragma unroll
            for (int kh = 0; kh < 2; ++kh) {
                const LAS unsigned char* Kb_ = lds + s_cur * MLA_BUF + (32 * kh + r32) * MLA_KP + hi * 16;
                f32x16 SA, SB;
#pragma unroll
                for (int ks = 0; ks < 6; ++ks) { const bf16x8 kf_ = *(const LAS bf16x8*)(Kb_ + ks * 32);
                    if (ks == 0) { SA = W64_MFMA(kf_, qfA[0], z16); SB = W64_MFMA(kf_, qfB[0], z16); } else { SA = W64_MFMA(kf_, qfA[ks], SA); SB = W64_MFMA(kf_, qfB[ks], SB); } }
                if (__any((mA != 0.f) || (mB != 0.f))) {
#pragma unroll
                    for (int i = 0; i < 16; ++i) { SA[i] -= mA; SB[i] -= mB; } }
                float lsA = 0.f, lsB = 0.f;
#pragma unroll
                for (int i = 0; i < 16; ++i) { SA[i] = __builtin_amdgcn_exp2f(SA[i]); SB[i] = __builtin_amdgcn_exp2f(SB[i]); lsA += SA[i]; lsB += SB[i]; }
                lA += lsA; lB += lsB;
                const float lxA = xhalf_sum(lsA), lxB = xhalf_sum(lsB);
                if (__any((lxA > 65536.f) || (lxB > 65536.f))) {
                    const float dA = (lxA > 65536.f) ? __log2f(lxA) : 0.f, dB = (lxB > 65536.f) ? __log2f(lxB) : 0.f; const float aA = __builtin_amdgcn_exp2f(-dA), aB = __builtin_amdgcn_exp2f(-dB);
                    mA += dA; mB += dB; lA *= aA; lB *= aB;
#pragma unroll
                    for (int i = 0; i < 16; ++i) { oA0[i] *= aA; oA1[i] *= aA; SA[i] *= aA; oB0[i] *= aB; oB1[i] *= aB; SB[i] *= aB; } }
#pragma unroll
                for (int s2 = 0; s2 < 2; ++s2) { const int kb = (32 * kh + 16 * s2 + 8 * hi) * 2;
                    u32x4 wa, wb;
                    wa.x = cvtpk(SA[8 * s2], SA[8 * s2 + 1]); wa.y = cvtpk(SA[8 * s2 + 2], SA[8 * s2 + 3]); wa.z = cvtpk(SA[8 * s2 + 4], SA[8 * s2 + 5]); wa.w = cvtpk(SA[8 * s2 + 6], SA[8 * s2 + 7]);
                    wb.x = cvtpk(SB[8 * s2], SB[8 * s2 + 1]); wb.y = cvtpk(SB[8 * s2 + 2], SB[8 * s2 + 3]); wb.z = cvtpk(SB[8 * s2 + 4], SB[8 * s2 + 5]); wb.w = cvtpk(SB[8 * s2 + 6], SB[8 * s2 + 7]);
                    const bf16x8 pa_ = __builtin_bit_cast(bf16x8, wa), pb_ = __builtin_bit_cast(bf16x8, wb);
                    const bf16x8 va_ = *(const LAS bf16x8*)(Vb_ + r32 * MLA_VP + kb), vb_ = *(const LAS bf16x8*)(Vb_ + (32 + r32) * MLA_VP + kb);
                    oA0 = W64_MFMA(va_, pa_, oA0); oA1 = W64_MFMA(vb_, pa_, oA1); oB0 = W64_MFMA(va_, pb_, oB0); oB1 = W64_MFMA(vb_, pb_, oB1); }
            }
            asm volatile("s_waitcnt vmcnt(3) lgkmcnt(0)\n\ts_barrier" ::: "memory");
            { const int t_ = s_cur; s_cur = s_nxt; s_nxt = s_pre; s_pre = t_; }
        }
        asm volatile("s_waitcnt vmcnt(0)" ::: "memory");
        __syncthreads();
        const float ilA = 1.f / xhalf_sum(lA), ilB = 1.f / xhalf_sum(lB);
        bf16_t* ypA = Y + (size_t)qrowA * 1024 + 512 + h * 64 + 4 * hi; bf16_t* ypB = Y + (size_t)qrowB * 1024 + 512 + h * 64 + 4 * hi;
#pragma unroll
        for (int g = 0; g < 4; ++g) { u32x2 w; w.x = pk2(oA0[4 * g] * ilA, oA0[4 * g + 1] * ilA); w.y = pk2(oA0[4 * g + 2] * ilA, oA0[4 * g + 3] * ilA); *(u32x2*)(ypA + 8 * g) = w;
            u32x2 x; x.x = pk2(oA1[4 * g] * ilA, oA1[4 * g + 1] * ilA); x.y = pk2(oA1[4 * g + 2] * ilA, oA1[4 * g + 3] * ilA); *(u32x2*)(ypA + 32 + 8 * g) = x;
            u32x2 y; y.x = pk2(oB0[4 * g] * ilB, oB0[4 * g + 1] * ilB); y.y = pk2(oB0[4 * g + 2] * ilB, oB0[4 * g + 3] * ilB); *(u32x2*)(ypB + 8 * g) = y;
            u32x2 z; z.x = pk2(oB1[4 * g] * ilB, oB1[4 * g + 1] * ilB); z.y = pk2(oB1[4 * g + 2] * ilB, oB1[4 * g + 3] * ilB); *(u32x2*)(ypB + 32 + 8 * g) = z; }
    }
#undef W64_MFMA
#undef W64_DMA
}

__device__ __forceinline__ float logsigmoid(float x) { return fminf(x, 0.f) - log1pf(expf(-fabsf(x))); }
__device__ __forceinline__ int chunk_row0(int b, int tc) { return tc < 4 ? NLAT + b * CTXL + 64 * tc : b * SEQ + 64 * (tc - 4); }
__device__ __forceinline__ int chunk_cdir(int d, int tc) { return d ? (tc < 4 ? 3 - tc : 135 - tc) : tc; }
__device__ __forceinline__ float wave_prefix_sum(float v, int lane) {
#pragma unroll
    for (int o = 1; o < 64; o <<= 1) { const float t = __shfl_up(v, o); if (lane >= o) v += t; }
    return v;
}
__device__ __forceinline__ float wave_prefix_max(float v, int lane) {
#pragma unroll
    for (int o = 1; o < 64; o <<= 1) { const float t = __shfl_up(v, o); if (lane >= o) v = fmaxf(v, t); }
    return v;
}
__device__ __forceinline__ float wave_max(float v) {
#pragma unroll
    for (int o = 1; o < 64; o <<= 1) v = fmaxf(v, __shfl_xor(v, o));
    return v;
}
__device__ __forceinline__ void stage_T(const bf16_t* src, LAS unsigned char* img, int pitchB, int tid) {
#pragma unroll
    for (int rep = 0; rep < 2; ++rep) { const int ci = tid + 512 * rep, t = ci & 63, dc = ci >> 6;
        const u32x4 w = *(const u32x4*)(src + (size_t)t * ABPAD + dc * 8);
        LAS unsigned char* d = img + (dc * 8) * pitchB + 2 * t;
        *(LAS bf16_t*)(d) = (bf16_t)(w.x & 0xffff); *(LAS bf16_t*)(d + pitchB) = (bf16_t)(w.x >> 16);
        *(LAS bf16_t*)(d + 2 * pitchB) = (bf16_t)(w.y & 0xffff); *(LAS bf16_t*)(d + 3 * pitchB) = (bf16_t)(w.y >> 16);
        *(LAS bf16_t*)(d + 4 * pitchB) = (bf16_t)(w.z & 0xffff); *(LAS bf16_t*)(d + 5 * pitchB) = (bf16_t)(w.z >> 16);
        *(LAS bf16_t*)(d + 6 * pitchB) = (bf16_t)(w.w & 0xffff); *(LAS bf16_t*)(d + 7 * pitchB) = (bf16_t)(w.w >> 16); }
}
__device__ __forceinline__ void stage_N(const bf16_t* src, LAS unsigned char* img, int tid) {
#pragma unroll
    for (int rep = 0; rep < 2; ++rep) { const int ci = tid + 512 * rep, t = ci >> 4, dc = ci & 15;
        *(LAS u32x4*)(img + t * 272 + dc * 16) = *(const u32x4*)(src + (size_t)t * ABPAD + dc * 8); }
}
__device__ __forceinline__ void mlstm_A(const P& p, LAS unsigned char* lds, int bid, int G, int tid, int wave, int lane) {
    const bf16_t* PROJ = (const bf16_t*)(p.ws + WS_PROJ); bf16_t* ST = (bf16_t*)(p.ws + WS_ST); float* SC = (float*)(p.ws + WS_SC);
    LAS unsigned char* KT = lds; LAS unsigned char* VT = lds + 18432; LAS float* W = (LAS float*)(lds + 36864);
    const int r32 = lane & 31, hi = lane >> 5;
    for (int item = bid; item < 2112; item += G) {
        const int bh = item / 132, tc = item % 132, b = bh >> 2, h = bh & 3; const int row0 = chunk_row0(b, tc);
        __syncthreads();
        stage_T(PROJ + (size_t)row0 * ABPAD + C_MK + h * 128, KT, 144, tid);
        stage_T(PROJ + (size_t)row0 * ABPAD + C_MV + h * 128, VT, 144, tid);
        if (wave < 2) { const int d = wave, t = d ? 63 - lane : lane; const bf16_t* g = PROJ + (size_t)(row0 + t) * ABPAD + C_MG;
            const float li = bf2f(g[(2 * d) * 4 + h]) + p.in[I_GATEB][(2 * d) * 4 + h]; const float lf = logsigmoid(bf2f(g[(2 * d + 1) * 4 + h]) + p.in[I_GATEB][(2 * d + 1) * 4 + h]);
            const float bs = wave_prefix_sum(lf, lane); const float blast = __shfl(bs, 63); const float gg = blast - bs + li; const float a = wave_max(gg);
            W[d * 64 + t] = __expf(gg - a);
            if (lane == 0) { float* sc = SC + ((size_t)(d * 16 + bh) * 132 + chunk_cdir(d, tc)) * 2; sc[0] = blast; sc[1] = a; } }
        __syncthreads();
        { const int d = wave >> 2, kt = wave & 3;
          bf16_t* slot = ST + ((size_t)(d * 16 + bh) * 132 + chunk_cdir(d, tc)) * ST_SLOT;
          bf16x8 af[4];
#pragma unroll
          for (int ks = 0; ks < 4; ++ks) { const u32x4 w = *(const LAS u32x4*)(KT + (32 * kt + r32) * 144 + (16 * ks + 8 * hi) * 2); const LAS float* ww = W + d * 64 + 16 * ks + 8 * hi;
              u32x4 o; o.x = pk2(bflo(w.x) * ww[0], bfhi(w.x) * ww[1]); o.y = pk2(bflo(w.y) * ww[2], bfhi(w.y) * ww[3]); o.z = pk2(bflo(w.z) * ww[4], bfhi(w.z) * ww[5]); o.w = pk2(bflo(w.w) * ww[6], bfhi(w.w) * ww[7]);
              af[ks] = __builtin_bit_cast(bf16x8, o); }
#pragma unroll
          for (int nt = 0; nt < 4; ++nt) { f32x16 acc;
#pragma unroll
              for (int i = 0; i < 16; ++i) acc[i] = 0.f;
#pragma unroll
              for (int ks = 0; ks < 4; ++ks) { const bf16x8 bfr = *(const LAS bf16x8*)(VT + (32 * nt + r32) * 144 + (16 * ks + 8 * hi) * 2); acc = __builtin_amdgcn_mfma_f32_32x32x16_bf16(af[ks], bfr, acc, 0, 0, 0); }
              bf16_t* op = slot + (size_t)(32 * nt + r32) * 128 + 32 * kt + 4 * hi;
#pragma unroll
              for (int g = 0; g < 4; ++g) { u32x2 w; w.x = pk2(acc[4 * g], acc[4 * g + 1]); w.y = pk2(acc[4 * g + 2], acc[4 * g + 3]); *(u32x2*)(op + 8 * g) = w; } }
        }
        if (tid < 256) { const int d = tid >> 7, dk = tid & 127; float s = 0.f;
#pragma unroll
            for (int c8 = 0; c8 < 8; ++c8) { const u32x4 w = *(const LAS u32x4*)(KT + dk * 144 + c8 * 16); const LAS float* ww = W + d * 64 + 8 * c8;
                s += (bflo(w.x) * ww[0] + bfhi(w.x) * ww[1]) + (bflo(w.y) * ww[2] + bfhi(w.y) * ww[3]) + (bflo(w.z) * ww[4] + bfhi(w.z) * ww[5]) + (bflo(w.w) * ww[6] + bfhi(w.w) * ww[7]); }
            ST[((size_t)(d * 16 + bh) * 132 + chunk_cdir(d, tc)) * ST_SLOT + 128 * 128 + dk] = (bf16_t)f2bf(s); }
    }
}
__device__ __forceinline__ void mlstm_B(const P& p, int bid, int tid) {
    const int gid = bid * 512 + tid;
    if (gid >= 32 * 2064) return;
    const int seq = gid / 2064, it = gid % 2064;
    bf16_t* slot = (bf16_t*)(p.ws + WS_ST) + (size_t)seq * 132 * ST_SLOT + it * 8;
    const float* sc = (const float*)(p.ws + WS_SC) + (size_t)seq * 132 * 2; float* ms = (float*)(p.ws + WS_MS) + seq * 132;
    float C[8];
#pragma unroll
    for (int e = 0; e < 8; ++e) C[e] = 0.f;
    float m = 0.f;
    for (int c0 = 0; c0 < 132; c0 += 12) {
        u32x4 w[12]; float bl[12], aa[12];
#pragma unroll
        for (int k = 0; k < 12; ++k) { w[k] = __builtin_nontemporal_load((const u32x4*)(slot + (size_t)(c0 + k) * ST_SLOT)); bl[k] = sc[(c0 + k) * 2]; aa[k] = sc[(c0 + k) * 2 + 1]; }
#pragma unroll
        for (int k = 0; k < 12; ++k) {
            u32x4 o; o.x = pk2(C[0], C[1]); o.y = pk2(C[2], C[3]); o.z = pk2(C[4], C[5]); o.w = pk2(C[6], C[7]);
            *(u32x4*)(slot + (size_t)(c0 + k) * ST_SLOT) = o;
            if (it == 0) ms[c0 + k] = m;
            const float mn = fmaxf(bl[k] + m, aa[k]); const float dec = __expf(bl[k] + m - mn), win = __expf(aa[k] - mn); m = mn;
            C[0] = dec * C[0] + win * bflo(w[k].x); C[1] = dec * C[1] + win * bfhi(w[k].x); C[2] = dec * C[2] + win * bflo(w[k].y); C[3] = dec * C[3] + win * bfhi(w[k].y);
            C[4] = dec * C[4] + win * bflo(w[k].z); C[5] = dec * C[5] + win * bfhi(w[k].z); C[6] = dec * C[6] + win * bflo(w[k].w); C[7] = dec * C[7] + win * bfhi(w[k].w);
        }
    }
}
__device__ __forceinline__ void mlstm_C(const P& p, LAS unsigned char* lds, int bid, int G, int tid, int wave, int lane) {
    const bf16_t* PROJ = (const bf16_t*)(p.ws + WS_PROJ); const bf16_t* ST = (const bf16_t*)(p.ws + WS_ST); const float* MS = (const float*)(p.ws + WS_MS);
    bf16_t* Y = (bf16_t*)p.out;
    LAS unsigned char* Qi = lds; LAS unsigned char* Ki = lds + 17408; LAS unsigned char* VTi = lds + 34816;
    LAS float* Bv = (LAS float*)(lds + 52224); LAS float* Uv = Bv + 128; LAS float* MTv = Uv + 128; LAS float* WIv = MTv + 128; LAS float* SS = WIv + 128;
    LAS unsigned char* NV = lds + 52224 + 4096;
    const int r32 = lane & 31, hi = lane >> 5, tt = wave & 1, dq = wave >> 1, t = 32 * tt + r32;
    const float qs = 0.08838834764831845f;
    for (int item = bid; item < 2112; item += G) {
        const int bh = item / 132, tc = item % 132, b = bh >> 2, h = bh & 3; const int row0 = chunk_row0(b, tc);
        const bf16_t* slot0 = ST + ((size_t)bh * 132 + chunk_cdir(0, tc)) * ST_SLOT; const bf16_t* slot1 = ST + ((size_t)(16 + bh) * 132 + chunk_cdir(1, tc)) * ST_SLOT;
        bf16x8 cf[8]; u32x2 owv[4];
#pragma unroll
        for (int ks = 0; ks < 8; ++ks) cf[ks] = __builtin_nontemporal_load((const bf16x8*)(slot0 + (size_t)(32 * dq + r32) * 128 + 16 * ks + 8 * hi));
#pragma unroll
        for (int g = 0; g < 4; ++g) owv[g] = *(const u32x2*)(PROJ + (size_t)(row0 + t) * ABPAD + C_MO + h * 128 + 32 * dq + 8 * g + 4 * hi);
        __syncthreads();
        stage_N(PROJ + (size_t)row0 * ABPAD + C_MQ + h * 128, Qi, tid);
        stage_N(PROJ + (size_t)row0 * ABPAD + C_MK + h * 128, Ki, tid);
        stage_T(PROJ + (size_t)row0 * ABPAD + C_MV + h * 128, VTi, 136, tid);
        if (tid < 32) { const int d = tid >> 4, ch = tid & 15; *(LAS u32x4*)(NV + d * 256 + ch * 16) = *(const u32x4*)((d ? slot1 : slot0) + 128 * 128 + ch * 8); }
        if (wave < 2) { const int d = wave, tk = d ? 63 - lane : lane; const bf16_t* g = PROJ + (size_t)(row0 + tk) * ABPAD + C_MG;
            const float li = bf2f(g[(2 * d) * 4 + h]) + p.in[I_GATEB][(2 * d) * 4 + h]; const float lf = logsigmoid(bf2f(g[(2 * d + 1) * 4 + h]) + p.in[I_GATEB][(2 * d + 1) * 4 + h]);
            const float bs = wave_prefix_sum(lf, lane); const float uu = li - bs; const float pm = wave_prefix_max(uu, lane);
            const float mc = MS[(size_t)(d * 16 + bh) * 132 + chunk_cdir(d, tc)]; const float mt = bs + fmaxf(mc, pm);
            Bv[d * 64 + tk] = bs; Uv[d * 64 + tk] = uu; MTv[d * 64 + tk] = mt; WIv[d * 64 + tk] = __expf(bs + mc - mt); }
        __syncthreads();
#define QF(ks) (*(const LAS bf16x8*)(Qi + t * 272 + (16 * (ks) + 8 * hi) * 2))
        f32x16 S0, S1;
#pragma unroll
        for (int i = 0; i < 16; ++i) { S0[i] = 0.f; S1[i] = 0.f; }
#pragma unroll
        for (int ks = 0; ks < 8; ++ks) { const bf16x8 k0 = *(const LAS bf16x8*)(Ki + r32 * 272 + (16 * ks + 8 * hi) * 2), k1 = *(const LAS bf16x8*)(Ki + (32 + r32) * 272 + (16 * ks + 8 * hi) * 2);
            const bf16x8 qq = QF(ks); S0 = __builtin_amdgcn_mfma_f32_32x32x16_bf16(k0, qq, S0, 0, 0, 0); S1 = __builtin_amdgcn_mfma_f32_32x32x16_bf16(k1, qq, S1, 0, 0, 0); }
        __builtin_amdgcn_sched_barrier(0);
        f32x16 hs;
#pragma unroll
        for (int i = 0; i < 16; ++i) hs[i] = 0.f;
#pragma unroll 1
        for (int d = 0; d < 2; ++d) {
            const float bt = Bv[d * 64 + t], mtt = MTv[d * 64 + t], wi = WIv[d * 64 + t] * qs; const int tsel = d ? 63 - t : t;
            f32x16 acc;
#pragma unroll
            for (int i = 0; i < 16; ++i) acc[i] = 0.f;
#pragma unroll
            for (int ks = 0; ks < 8; ++ks) acc = __builtin_amdgcn_mfma_f32_32x32x16_bf16(cf[ks], QF(ks), acc, 0, 0, 0);
            __builtin_amdgcn_sched_barrier(0);
#pragma unroll
            for (int ks = 0; ks < 8; ++ks) cf[ks] = __builtin_nontemporal_load((const bf16x8*)(slot1 + (size_t)(32 * dq + r32) * 128 + 16 * ks + 8 * hi));
            float dn = 0.f;
#pragma unroll
            for (int c8 = 0; c8 < 8; ++c8) { const u32x4 qw = *(const LAS u32x4*)(Qi + t * 272 + (64 * hi + 8 * c8) * 2); const u32x4 nw = *(const LAS u32x4*)(NV + d * 256 + (64 * hi + 8 * c8) * 2);
                dn += (bflo(qw.x) * bflo(nw.x) + bfhi(qw.x) * bfhi(nw.x)) + (bflo(qw.y) * bflo(nw.y) + bfhi(qw.y) * bfhi(nw.y)) + (bflo(qw.z) * bflo(nw.z) + bfhi(qw.z) * bfhi(nw.z)) + (bflo(qw.w) * bflo(nw.w) + bfhi(qw.w) * bfhi(nw.w)); }
            dn = xhalf_sum(dn);
            __builtin_amdgcn_sched_barrier(0);
#pragma unroll
            for (int i = 0; i < 16; ++i) acc[i] *= wi;
            float rs = 0.f;
#pragma unroll
            for (int st = 0; st < 2; ++st) { float pv[16];
#pragma unroll
                for (int i = 0; i < 16; ++i) { const int sp = 32 * st + (i & 3) + 8 * (i >> 2) + 4 * hi;
                    const bool vld = (d ? 63 - sp : sp) <= tsel;
                    const float e = __expf(bt + Uv[d * 64 + sp] - mtt);
                    pv[i] = vld ? (st ? S1[i] : S0[i]) * qs * e : 0.f; rs += pv[i]; }
#pragma unroll
                for (int s = 0; s < 2; ++s) {
                    u32x4 w; w.x = cvtpk(pv[8 * s], pv[8 * s + 1]); w.y = cvtpk(pv[8 * s + 2], pv[8 * s + 3]); w.z = cvtpk(pv[8 * s + 4], pv[8 * s + 5]); w.w = cvtpk(pv[8 * s + 6], pv[8 * s + 7]);
                    const int kb = (32 * st + 16 * s + 4 * hi) * 2;
                    const u32x2 a0 = *(const LAS u32x2*)(VTi + (32 * dq + r32) * 136 + kb), a1 = *(const LAS u32x2*)(VTi + (32 * dq + r32) * 136 + kb + 16);
                    acc = __builtin_amdgcn_mfma_f32_32x32x16_bf16(__builtin_bit_cast(bf16x8, (u32x4){a0.x, a0.y, a1.x, a1.y}), __builtin_bit_cast(bf16x8, w), acc, 0, 0, 0); } }
            __builtin_amdgcn_sched_barrier(0);
            const float den = wi * dn + xhalf_sum(rs);
            const float inv = 1.f / fmaxf(fabsf(den), __expf(-mtt));
#pragma unroll
            for (int i = 0; i < 16; ++i) hs[i] += acc[i] * inv;
        }
        float ssq = 0.f;
#pragma unroll
        for (int i = 0; i < 16; ++i) ssq += hs[i] * hs[i];
        ssq = xhalf_sum(ssq);
        if (hi == 0) SS[dq * 64 + t] = ssq;
        __syncthreads();
        const float rstd = rsqrtf(((SS[t] + SS[64 + t]) + (SS[128 + t] + SS[192 + t])) * (1.f / 128.f) + EPS);
        const int row = row0 + t;
#pragma unroll
        for (int g = 0; g < 4; ++g) { const int dv = 32 * dq + 8 * g + 4 * hi;
            const u32x2 ow = owv[g]; const f32x4 gg = *(const f32x4*)(p.in[I_MNG] + h * 128 + dv);
            const float y0 = hs[4 * g] * rstd * gg.x / (1.f + __expf(-bflo(ow.x))), y1 = hs[4 * g + 1] * rstd * gg.y / (1.f + __expf(-bfhi(ow.x)));
            const float y2 = hs[4 * g + 2] * rstd * gg.z / (1.f + __expf(-bflo(ow.y))), y3 = hs[4 * g + 3] * rstd * gg.w / (1.f + __expf(-bfhi(ow.y)));
            u32x2 w; w.x = pk2(y0, y1); w.y = pk2(y2, y3); *(u32x2*)(Y + (size_t)row * 1024 + h * 128 + dv) = w; }
    }
}

struct EpiQKV1 {
    static constexpr bool PERM = true, AFTER_DRAIN = false;
    bf16_t* O; bf16_t* VT1;
    __device__ __forceinline__ void operator()(const pg8::f32x4 (&acc)[2][2][4][2], const pg8::Unit& u, int wr, int wc, int fr, int fq) const {
        const int row0 = u.pm * 256 + wr * 64 + fr, col0 = u.pn * 256 + wc * 32 + 8 * fq;
#pragma unroll
        for (int ai = 0; ai < 2; ++ai)
#pragma unroll
            for (int m = 0; m < 4; ++m) { const int row = row0 + ai * 128 + m * 16;
                int b, key; if (row < NLAT) { b = row >> 13; key = row & 8191; } else { b = (row - NLAT) >> 8; key = SEQ + ((row - NLAT) & 255); }
#pragma unroll
                for (int bj = 0; bj < 2; ++bj) { const pg8::f32x4 v0 = acc[ai][bj][m][0], v1 = acc[ai][bj][m][1]; const int c = col0 + bj * 128;
                    if (u.pn < 8) { u32x4 w; w.x = pk2(v0[0], v0[1]); w.y = pk2(v0[2], v0[3]); w.z = pk2(v1[0], v1[1]); w.w = pk2(v1[2], v1[3]); *(u32x4*)(O + (size_t)row * 3072 + c) = w; }
                    else { const int cv = c - 2048; bf16_t* vp = VT1 + ((size_t)(b * 16 + (cv >> 6)) * 64 + (cv & 63)) * 8448 + key;
#pragma unroll
                        for (int e = 0; e < 4; ++e) { vp[(size_t)e * 8448] = (bf16_t)f2bf(v0[e]); vp[(size_t)(e + 4) * 8448] = (bf16_t)f2bf(v1[e]); } } } }
    }
};
constexpr int NA_KC = 0, NA_VTC = 36864, NA_BT = 70656, NA_WIN = 72960, NA_WK = 9216, NA_WBUF = 9216 + 8704;
template <int SKIP> __device__ __forceinline__ void na_phase(const P& p, LAS unsigned char* lds, int bid, int G, int tid, int wave, int lane) {
    const bf16_t* QKV = (const bf16_t*)(p.ws + WS_BIG); const bf16_t* VT1 = (const bf16_t*)(p.ws + WS_VT1); bf16_t* Y = SKIP ? (bf16_t*)(p.ws + WS_XN) : (bf16_t*)p.out;
    LAS unsigned char* Kc = lds + NA_KC; LAS unsigned char* VTc = lds + NA_VTC; LAS float* BT0 = (LAS float*)(lds + NA_BT); LAS float* BT = BT0 + 32;
    const int r16 = lane & 15, g4 = lane >> 4;
    const float L2E = 1.4426950408889634f, sc = 0.125f * L2E;
    const int st_t = tid >> 3, st_c = tid & 7;
    for (int item = bid; item < 1024; item += G) {
        const int bh = item >> 4, R = item & 15, b = bh >> 4, h = bh & 15;
        const bf16_t* VTh = VT1 + (size_t)bh * 64 * 8448;
        const int krlo = min(max(8 * R - 4, 0), 120), krhi = min(max(8 * R + 3, 0), 120) + 7;
        __syncthreads();
#pragma unroll
        for (int rep = 0; rep < 4; ++rep) { const int ci = tid + 512 * rep;
            { const int row = ci >> 3, ch = ci & 7; *(LAS u32x4*)(Kc + row * 144 + ch * 16) = *(const u32x4*)(QKV + (size_t)(NLAT + b * CTXL + row) * 3072 + 1024 + h * 64 + ch * 8); }
            { const int d = ci >> 5, ch = ci & 31; *(LAS u32x4*)(VTc + d * 528 + ch * 16) = *(const u32x4*)(VTh + (size_t)d * 8448 + SEQ + ch * 8); } }
        if (tid < 465) BT[tid] = p.in[I_RELB][h * 465 + tid] * L2E; else if (tid < 465 + 32) BT[tid] = 0.f;
        if (tid < 32) BT0[tid] = 0.f;
        { const u32x4 kw = *(const u32x4*)(QKV + (size_t)(b * SEQ + krlo * 64 + st_t) * 3072 + 1024 + h * 64 + st_c * 8); const u32x4 vw = *(const u32x4*)(VTh + (size_t)st_t * 8448 + krlo * 64 + st_c * 8);
          LAS unsigned char* wb = lds + NA_WIN; *(LAS u32x4*)(wb + st_t * 144 + st_c * 16) = kw;
          *(LAS u32x2*)(wb + NA_WK + st_t * 136 + st_c * 16) = (u32x2){vw.x, vw.y}; *(LAS u32x2*)(wb + NA_WK + st_t * 136 + st_c * 16 + 8) = (u32x2){vw.z, vw.w}; }
        __syncthreads();
        const int r = 8 * R + wave, rs = min(max(r - 4, 0), 120);
        const int qrow0 = b * SEQ + r * 64;
        bf16x8 qf[4][2]; unsigned vmask[4]; f32x4 o[4][4]; float ls[4];
#pragma unroll
        for (int g = 0; g < 4; ++g) { const int qcol = 16 * g + r16, cs = min(max(qcol - 8, 0), 48), cA = (g == 0) ? 0 : (g == 1) ? 8 : (g == 2) ? 24 : 32;
#pragma unroll
            for (int ks = 0; ks < 2; ++ks) { const u32x4 w = *(const u32x4*)(QKV + (size_t)(qrow0 + qcol) * 3072 + h * 64 + 32 * ks + 8 * g4);
                u32x4 o4; o4.x = pk2(bflo(w.x) * sc, bfhi(w.x) * sc); o4.y = pk2(bflo(w.y) * sc, bfhi(w.y) * sc); o4.z = pk2(bflo(w.z) * sc, bfhi(w.z) * sc); o4.w = pk2(bflo(w.w) * sc, bfhi(w.w) * sc);
                qf[g][ks] = __builtin_bit_cast(bf16x8, o4); }
            vmask[g] = (0xffffu << (cs - cA)) >> (4 * g4);
#pragma unroll
            for (int dt = 0; dt < 4; ++dt) o[g][dt] = (f32x4){0.f, 0.f, 0.f, 0.f};
            ls[g] = 0.f; }
        const f32x4 z4 = {0.f, 0.f, 0.f, 0.f};
        for (int kr = krlo; kr <= krhi; ++kr) {
            const int cur = (kr - krlo) & 1; const bool more = kr < krhi;
            u32x4 kw = {0, 0, 0, 0}, vw = {0, 0, 0, 0};
            if (more) { kw = *(const u32x4*)(QKV + (size_t)(b * SEQ + (kr + 1) * 64 + st_t) * 3072 + 1024 + h * 64 + st_c * 8); vw = *(const u32x4*)(VTh + (size_t)st_t * 8448 + (kr + 1) * 64 + st_c * 8); }
            if (!(SKIP & 1) && kr >= rs && kr <= rs + 7) {
                const LAS unsigned char* Kw = lds + NA_WIN + cur * NA_WBUF; const LAS unsigned char* Vw = Kw + NA_WK;
                const LAS float* btr = BT + (kr - r + 7) * 31 + 4 * g4 + 15 - r16;
#pragma unroll
                for (int g = 0; g < 4; ++g) { const int cA = (g == 0) ? 0 : (g == 1) ? 8 : (g == 2) ? 24 : 32;
                    f32x4 sw[2];
#pragma unroll
                    for (int blk = 0; blk < 2; ++blk) { const int cst = cA + 16 * blk;
                        const bf16x8 k0 = *(const LAS bf16x8*)(Kw + (cst + r16) * 144 + 8 * g4 * 2), k1 = *(const LAS bf16x8*)(Kw + (cst + r16) * 144 + (32 + 8 * g4) * 2);
                        f32x4 acc = __builtin_amdgcn_mfma_f32_16x16x32_bf16(k0, qf[g][0], z4, 0, 0, 0); acc = __builtin_amdgcn_mfma_f32_16x16x32_bf16(k1, qf[g][1], acc, 0, 0, 0);
#pragma unroll
                        for (int j = 0; j < 4; ++j) { const float sv = acc[j] + btr[cst - 16 * g + j]; const float v = __builtin_amdgcn_exp2f(((vmask[g] >> (16 * blk + j)) & 1u) ? sv : -1e30f); sw[blk][j] = v; ls[g] += v; } }
                    u32x4 w; w.x = cvtpk(sw[0][0], sw[0][1]); w.y = cvtpk(sw[0][2], sw[0][3]); w.z = cvtpk(sw[1][0], sw[1][1]); w.w = cvtpk(sw[1][2], sw[1][3]);
                    const bf16x8 pb = __builtin_bit_cast(bf16x8, w);
#pragma unroll
                    for (int dt = 0; dt < 4; ++dt) { const LAS unsigned char* vr = Vw + (16 * dt + r16) * 136 + (cA + 4 * g4) * 2; const u32x2 a0 = *(const LAS u32x2*)(vr), a1 = *(const LAS u32x2*)(vr + 32);
                        o[g][dt] = __builtin_amdgcn_mfma_f32_16x16x32_bf16(__builtin_bit_cast(bf16x8, (u32x4){a0.x, a0.y, a1.x, a1.y}), pb, o[g][dt], 0, 0, 0); }
                    if (g & 1) __builtin_amdgcn_sched_barrier(0); }
            }
            if (more) { LAS unsigned char* wb = lds + NA_WIN + (cur ^ 1) * NA_WBUF; *(LAS u32x4*)(wb + st_t * 144 + st_c * 16) = kw;
                *(LAS u32x2*)(wb + NA_WK + st_t * 136 + st_c * 16) = (u32x2){vw.x, vw.y}; *(LAS u32x2*)(wb + NA_WK + st_t * 136 + st_c * 16 + 8) = (u32x2){vw.z, vw.w}; }
            __syncthreads();
        }
#pragma unroll
        for (int g = 0; g < 4; ++g) {
#pragma unroll 1
            for (int cq = 0; cq < ((SKIP & 2) ? 0 : 4); ++cq) {
                f32x4 sx[4];
#pragma unroll
                for (int cb = 0; cb < 4; ++cb) { f32x4 acc = z4;
#pragma unroll
                    for (int ks = 0; ks < 2; ++ks) { const bf16x8 kf = *(const LAS bf16x8*)(Kc + (64 * cq + 16 * cb + r16) * 144 + (32 * ks + 8 * g4) * 2); acc = __builtin_amdgcn_mfma_f32_16x16x32_bf16(kf, qf[g][ks], acc, 0, 0, 0); }
                    sx[cb] = acc; }
                float l2 = 0.f;
#pragma unroll
                for (int i = 0; i < 4; ++i)
#pragma unroll
                    for (int j = 0; j < 4; ++j) { sx[i][j] = __builtin_amdgcn_exp2f(sx[i][j]); l2 += sx[i][j]; }
                ls[g] += l2;
#pragma unroll
                for (int cp = 0; cp < 2; ++cp) { u32x4 w; w.x = cvtpk(sx[2 * cp][0], sx[2 * cp][1]); w.y = cvtpk(sx[2 * cp][2], sx[2 * cp][3]); w.z = cvtpk(sx[2 * cp + 1][0], sx[2 * cp + 1][1]); w.w = cvtpk(sx[2 * cp + 1][2], sx[2 * cp + 1][3]);
                    const bf16x8 pb = __builtin_bit_cast(bf16x8, w);
#pragma unroll
                    for (int dt = 0; dt < 4; ++dt) { const LAS unsigned char* vr = VTc + (16 * dt + r16) * 528 + (64 * cq + 32 * cp + 4 * g4) * 2; const u32x2 a0 = *(const LAS u32x2*)(vr), a1 = *(const LAS u32x2*)(vr + 32);
                        o[g][dt] = __builtin_amdgcn_mfma_f32_16x16x32_bf16(__builtin_bit_cast(bf16x8, (u32x4){a0.x, a0.y, a1.x, a1.y}), pb, o[g][dt], 0, 0, 0); } }
            }
            float lt = ls[g] + __shfl_xor(ls[g], 16); lt += __shfl_xor(lt, 32);
            const float il = 1.f / lt;
            bf16_t* yp = Y + (size_t)(qrow0 + 16 * g + r16) * 1024 + h * 64 + 4 * g4;
#pragma unroll
            for (int dt = 0; dt < 4; ++dt) { u32x2 w; w.x = pk2(o[g][dt][0] * il, o[g][dt][1] * il); w.y = pk2(o[g][dt][2] * il, o[g][dt][3] * il); *(u32x2*)(yp + 16 * dt) = w; }
        }
    }
}

__device__ __forceinline__ void final_norm_phase(const P& p, int gw, int NGW, int lane) {
    const bf16_t* XR = (const bf16_t*)(p.ws + WS_XR);
    for (int row0 = gw; row0 < NLAT; row0 += 2 * NGW) {
        f32x4 v[2][4]; float s[2] = {0.f, 0.f};
#pragma unroll
        for (int r = 0; r < 2; ++r) { const int row = min(row0 + r * NGW, NLAT - 1); const u32x2* x16 = (const u32x2*)(XR + (size_t)row * DM) + lane;
#pragma unroll
            for (int j = 0; j < 4; ++j) { const u32x2 w = __builtin_nontemporal_load(x16 + 64 * j); v[r][j] = (f32x4){bflo(w.x), bfhi(w.x), bflo(w.y), bfhi(w.y)}; s[r] += (v[r][j].x * v[r][j].x + v[r][j].y * v[r][j].y) + (v[r][j].z * v[r][j].z + v[r][j].w * v[r][j].w); } }
        const float rs0 = rsqrtf(wave_sum(s[0]) * (1.f / DM) + EPS), rs1 = rsqrtf(wave_sum(s[1]) * (1.f / DM) + EPS);
        const f32x4* g4 = (const f32x4*)p.in[I_FNG] + lane;
#pragma unroll
        for (int r = 0; r < 2; ++r) { const int row = row0 + r * NGW;
            if (row < NLAT) { f32x4* xo = (f32x4*)(p.out + (size_t)row * DM) + lane; const float rstd = r ? rs1 : rs0;
#pragma unroll
                for (int j = 0; j < 4; ++j) __builtin_nontemporal_store(v[r][j] * rstd * g4[64 * j], xo + 64 * j); } }
    }
}

template <class Epi> __device__ __forceinline__ void run_gemm(LAS unsigned char* lds, const bf16_t* A, const bf16_t* Bt, int M, int N, int K, int G, int bid, const Epi& E, int ld = 0) {
    int Kv = K; asm volatile("" : "+s"(Kv));
    pg8::Gemm g{A, Bt, M, N, Kv, ld ? ld : Kv}; pg8::StaticOrder S; S.init(M, N, G, bid);
    pg8::gemm_phase<Epi, pg8::StaticOrder, true, true>(lds, g, S, E);
}
struct EpiPartial {
    static constexpr bool PERM = true, AFTER_DRAIN = false;
    float* P;
    __device__ __forceinline__ void operator()(const pg8::f32x4 (&acc)[2][2][4][2], const pg8::Unit& u, int wr, int wc, int fr, int fq) const {
        const int row0 = u.pm * 256 + wr * 64 + fr, col0 = u.pn * 256 + wc * 32 + 8 * fq;
#pragma unroll
        for (int ai = 0; ai < 2; ++ai)
#pragma unroll
            for (int m = 0; m < 4; ++m) { float* op = P + (size_t)(row0 + ai * 128 + m * 16) * DM + col0;
#pragma unroll
                for (int bj = 0; bj < 2; ++bj) { *(f32x4*)(op + bj * 128) = acc[ai][bj][m][0]; *(f32x4*)(op + bj * 128 + 4) = acc[ai][bj][m][1]; } }
    }
};
__device__ __forceinline__ void ctx_splitk_gemm(LAS unsigned char* lds, const bf16_t* Actx, const bf16_t* Bt, int Ktot, int NS, int G, int bid, float* P) {
    const int Ks = Ktot / NS;
#pragma unroll 1
    for (int s = 0; s < NS; ++s) run_gemm(lds, Actx + s * Ks, Bt + s * Ks, NCTX, 1024, Ks, G, (bid + G - 16 * s) % G, EpiPartial{P + (size_t)s * NCTX * DM}, Ktot);
}
#define XB_TMO      128
#define XB_XCNT(j)  (256  + 64 * (j))
#define XB_XSUB(j)  (1280 + 64 * (j))
#define XB_XGEN(j)  (2304 + 64 * (j))
#define XB_TOP      3328
#define XB_TOPGEN   3392
#define XCD_BAR_WORDS 3456
#define XB_SPIN_CAP (1u << 18)

__device__ __forceinline__ unsigned xb_ld(unsigned* p)              { return __hip_atomic_load(p, __ATOMIC_RELAXED, __HIP_MEMORY_SCOPE_AGENT); }
__device__ __forceinline__ unsigned xb_add(unsigned* p, unsigned v) { return __hip_atomic_fetch_add(p, v, __ATOMIC_RELAXED, __HIP_MEMORY_SCOPE_AGENT); }
__device__ __forceinline__ unsigned xb_xcc_id() { return (unsigned)__builtin_amdgcn_s_getreg((3 << 11) | 20) & 0xFu; }
#define XB_SPIN(cond, bar) do { unsigned _sp = 0; while (cond) { __builtin_amdgcn_s_sleep(1); \
    if ((++_sp & 255u) == 0u) { if (xb_ld(&(bar)[XB_TMO])) break; if (_sp > XB_SPIN_CAP) { atomicAdd(&(bar)[XB_TMO], 1u); break; } } } } while (0)

struct XcdBarrier {
    unsigned* bar; unsigned x;
    volatile LAS unsigned* st;
};

__device__ __forceinline__ XcdBarrier xcd_barrier_post(unsigned* bar, volatile LAS unsigned* st) {
    XcdBarrier b; b.bar = bar; b.x = xb_xcc_id(); b.st = st;
    if (threadIdx.x == 0) (void)xb_add(&bar[XB_XCNT(b.x)], 1u);
    return b;
}
__device__ __forceinline__ void xcd_barrier_complete(unsigned* bar, unsigned x, unsigned& nloc, unsigned& nx) {
    const unsigned G = gridDim.x * gridDim.y * gridDim.z;
    unsigned sum, cnt, mine, sp = 0u;
    for (;;) {
        sum = 0u; cnt = 0u; mine = 0u;
#pragma unroll
        for (unsigned j = 0; j < 16; ++j) { const unsigned c = xb_ld(&bar[XB_XCNT(j)]); sum += c; cnt += (c > 0u) ? 1u : 0u; mine = (j == x) ? c : mine; }
        if (sum == G) break;
        __builtin_amdgcn_s_sleep(1);
        if ((++sp & 255u) == 0u) { if (xb_ld(&bar[XB_TMO])) break; if (sp > XB_SPIN_CAP) { atomicAdd(&bar[XB_TMO], 1u); break; } }
    }
    nloc = mine > 0u ? mine : 1u; nx = cnt > 0u ? cnt : 1u;
}

__device__ __forceinline__ void xcd_barrier(const XcdBarrier& b) {
    asm volatile("s_waitcnt vmcnt(0)" ::: "memory");
    __syncthreads();
    if (threadIdx.x == 0) {
        unsigned* bar = b.bar;
        __builtin_amdgcn_s_waitcnt(0);
        unsigned nloc = b.st[0], nx = b.st[1];
        if (nloc == 0u) { xcd_barrier_complete(bar, b.x, nloc, nx); b.st[0] = nloc; b.st[1] = nx; }
        const unsigned old = xb_add(&bar[XB_XSUB(b.x)], 1u);
        const unsigned gen = old / nloc;
        if (old + 1u == (gen + 1u) * nloc) {
            __builtin_amdgcn_fence(__ATOMIC_RELEASE, "agent");
            asm volatile("s_waitcnt vmcnt(0)" ::: "memory");
            const unsigned og = xb_add(&bar[XB_TOP], 1u);
            const unsigned tg = og / nx;
            if (og + 1u == (tg + 1u) * nx) xb_add(&bar[XB_TOPGEN], 1u);
            else XB_SPIN(xb_ld(&bar[XB_TOPGEN]) == tg, bar);
            __builtin_amdgcn_fence(__ATOMIC_ACQUIRE, "agent");
            xb_add(&bar[XB_XGEN(b.x)], 1u);
            asm volatile("s_waitcnt vmcnt(0)" ::: "memory");
        } else {
            XB_SPIN(xb_ld(&bar[XB_XGEN(b.x)]) == gen, bar);
            __builtin_amdgcn_fence(__ATOMIC_ACQUIRE, "agent");
            asm volatile("s_waitcnt vmcnt(0)" ::: "memory");
        }
    }
    __syncthreads();
}

constexpr int N_PHASES = 64;
#ifndef REP_MASK
#define REP_MASK 0u
#endif
__global__ void __launch_bounds__(512) fwd_kernel(P p) {
    extern __shared__ __attribute__((aligned(16))) unsigned char lds_raw[];
    LAS unsigned char* lds = (LAS unsigned char*)lds_raw;
    cg::grid_group grid = cg::this_grid();
    const int tid = threadIdx.x, lane = tid & 63, wave = __builtin_amdgcn_readfirstlane(tid >> 6);
    const int G = gridDim.x, bid = blockIdx.x, gw = bid * 8 + wave, NGW = G * 8;
    unsigned char* ws = p.ws;
    float* MOD = (float*)(ws + WS_MOD); float* XCTX = (float*)(ws + WS_XCTX);
    bf16_t* XN = (bf16_t*)(ws + WS_XN); bf16_t* Y = (bf16_t*)p.out; bf16_t* U = (bf16_t*)(ws + WS_BIG);
    bf16_t* XR = (bf16_t*)(ws + WS_XR); float* P2 = (float*)((unsigned char*)p.out + 66 * MiB);
    const int lo = p.ph_lo, hi = p.ph_hi;
    volatile LAS unsigned* MISC = (volatile LAS unsigned*)(lds + LDS_BYTES - 64);
    if (tid < 16) MISC[tid] = 0u;
    unsigned* barw = (unsigned*)(ws + WS_BAR);
    if (bid == 0) for (int i = tid; i < XCD_BAR_WORDS; i += 512) barw[i] = 0u;
    __syncthreads();
    grid.sync();
    XcdBarrier xbar = xcd_barrier_post(barw, MISC + 8);
    int k = 0;
#define PHASE(...) do { if (lo <= k && k < hi) { __VA_ARGS__; if ((REP_MASK >> k) & 1u) { xcd_barrier(xbar); __VA_ARGS__; } } if (lo <= k && k + 1 < hi) xcd_barrier(xbar); ++k; } while (0)
    PHASE(p0_phase(p, lds, bid, G, tid, wave, lane));
    PHASE(modulate_phase(p.in[I_X], p.in[I_CTX], MT, p.in[I_N1G], MOD, 0, 1024, XN, gw, NGW, lane));
    PHASE(run_gemm(lds, XN, (const bf16_t*)(ws + WS_WIN), MT, ABPAD, 1024, G, bid, EpiBf16<0>{(bf16_t*)(ws + WS_PROJ), ABPAD}));
    PHASE(p3a_phase(p, gw, NGW, lane));
    PHASE(run_gemm(lds, (const bf16_t*)(ws + WS_CQN), (const bf16_t*)(ws + WS_WUQ), MT, 768, 256, G, bid, EpiBf16<0>{(bf16_t*)(ws + WS_QA), 768});
          run_gemm(lds, (const bf16_t*)(ws + WS_CKVN), (const bf16_t*)(ws + WS_WUKV), MT, 1024, 128, G, bid, EpiKV{(bf16_t*)(ws + WS_KA), (bf16_t*)(ws + WS_VT)}));
    PHASE(mla_attn_w64(p, lds, bid, G, tid, wave, lane));
#ifdef MLA_PROBE
    xcd_barrier(xbar); mla_attn_phase<MLA_PROBE>(p, lds, bid, G, tid, wave, lane); xcd_barrier(xbar);
#endif
    PHASE(mlstm_A(p, lds, bid, G, tid, wave, lane));
    PHASE(mlstm_B(p, bid, tid));
    PHASE(mlstm_C(p, lds, bid, G, tid, wave, lane));
    PHASE(run_gemm(lds, Y, (const bf16_t*)(ws + WS_WOUT), NLAT, 1024, 1024, G, bid, EpiRes16{p.in[I_X], XR, MOD + 2048});
          ctx_splitk_gemm(lds, Y + (size_t)NLAT * 1024, (const bf16_t*)(ws + WS_WOUT), 1024, 4, G, bid, (float*)(ws + WS_BIG)));
    PHASE(modulate_phase(nullptr, p.in[I_CTX], MT, p.in[I_N2G], MOD, 3072, 4096, XN, gw, NGW, lane, (const float*)(ws + WS_BIG), 4, MOD + 4 * 6144 + 2048, XCTX, XR));
    PHASE(run_gemm(lds, XN, (const bf16_t*)(ws + WS_W1), MT, FF, 1024, G, bid, EpiBf16<2>{U, FF}));
    PHASE(run_gemm(lds, U, (const bf16_t*)(ws + WS_W2), NLAT, 1024, FF, G, bid, EpiRes16{nullptr, XR, MOD + 5120});
          ctx_splitk_gemm(lds, U + (size_t)NLAT * FF, (const bf16_t*)(ws + WS_W2), FF, 8, G, bid, P2));
    PHASE(modulate_phase(nullptr, XCTX, MT, p.in[I_N1G] + 1024, MOD + 5 * 6144, 0, 1024, XN, gw, NGW, lane, P2, 8, MOD + 4 * 6144 + 5120, nullptr, XR));
    PHASE(run_gemm(lds, XN, (const bf16_t*)(ws + WS_WNA), MT, 3072, 1024, G, bid, EpiQKV1{U, (bf16_t*)(ws + WS_VT1)}));
    PHASE(na_phase<0>(p, lds, bid, G, tid, wave, lane));
#ifdef NA_PROBE
    xcd_barrier(xbar); na_phase<NA_PROBE>(p, lds, bid, G, tid, wave, lane); xcd_barrier(xbar);
#endif
    PHASE(run_gemm(lds, Y, (const bf16_t*)(ws + WS_WNAOUT), NLAT, 1024, 1024, G, bid, EpiRes16{nullptr, XR, MOD + 5 * 6144 + 2048}));
    PHASE(modulate_phase(nullptr, XCTX, NLAT, p.in[I_N2G] + 1024, MOD + 5 * 6144, 3072, 4096, XN, gw, NGW, lane, nullptr, 0, nullptr, nullptr, XR));
    PHASE(run_gemm(lds, XN, (const bf16_t*)(ws + WS_W1) + (size_t)FF * 1024, NLAT, FF, 1024, G, bid, EpiBf16<2>{U, FF}));
    PHASE(run_gemm(lds, U, (const bf16_t*)(ws + WS_W2) + (size_t)FF * 1024, NLAT, 1024, FF, G, bid, EpiRes16{nullptr, XR, MOD + 5 * 6144 + 5120}));
    PHASE(final_norm_phase(p, gw, NGW, lane));
#undef PHASE
}

extern "C" void kernel_launch(void* const* d_in, const int* in_sizes, int n_in, void* d_out, int out_size, void* d_ws, size_t ws_size, hipStream_t stream) {
    static int grid = 0;
    if (grid == 0) {
        if (n_in != 22 || out_size != NLAT * DM || ws_size < WS_END) { fprintf(stderr, "kernel_launch: unexpected shapes (n_in %d out %d ws %zu)\n", n_in, out_size, ws_size); grid = -1; return; }
        int dev = 0, cus = 0, per_cu = 0;
        if (hipGetDevice(&dev) != hipSuccess || hipDeviceGetAttribute(&cus, hipDeviceAttributeMultiprocessorCount, dev) != hipSuccess) { grid = -1; return; }
        if (hipFuncSetAttribute((const void*)fwd_kernel, hipFuncAttributeMaxDynamicSharedMemorySize, LDS_BYTES) != hipSuccess) { fprintf(stderr, "kernel_launch: hipFuncSetAttribute failed\n"); grid = -1; return; }
        if (hipOccupancyMaxActiveBlocksPerMultiprocessor(&per_cu, (const void*)fwd_kernel, 512, LDS_BYTES) != hipSuccess || per_cu < 1) { fprintf(stderr, "kernel_launch: occupancy query says %d\n", per_cu); per_cu = 1; }
        (void)hipGetLastError();
        grid = cus;
    }
    if (grid < 0) return;
    P a{};
    for (int i = 0; i < 22; ++i) a.in[i] = (const float*)d_in[i];
    a.out = (float*)d_out; a.ws = (unsigned char*)d_ws; a.ph_lo = 0; a.ph_hi = N_PHASES;
    void* args[] = {&a};
    hipError_t e = hipLaunchCooperativeKernel((const void*)fwd_kernel, dim3(grid), dim3(512), args, LDS_BYTES, stream);
    if (e != hipSuccess) fprintf(stderr, "cooperative launch failed: %s (grid %d)\n", hipGetErrorString(e), grid);
}
```

```cpp
#include <hip/hip_runtime.h>
#include <hip/hip_cooperative_groups.h>
#include <cstdio>
#include <cstdint>
namespace cg = cooperative_groups;
namespace pg8 {
#define PG8_LAS __attribute__((address_space(3)))
typedef unsigned short bf16_t;
typedef short bf16x8 __attribute__((ext_vector_type(8)));
typedef float f32x4 __attribute__((ext_vector_type(4)));
typedef unsigned u32x4 __attribute__((ext_vector_type(4)));
constexpr int BM = 256, BK = 64, HALF = 128, HTB = HALF * BK * 2  , STAGE_BYTES = 8 * HTB, NXCD = 8, WGM = 8;

__host__ __device__ __forceinline__ int lds_byte(int r, int c) { const int st = (r >> 4) * 2 + (c >> 5), rr = r & 15, cc = c & 31, ob = rr * 64 + cc * 2; return st * 1024 + (ob ^ (((ob >> 9) & 1) << 5)); }
__host__ __device__ __forceinline__ void stage_rc(int b, int& R, int& C) { const int st = b / 1024, sb = b % 1024, swz = sb ^ (((sb >> 9) & 1) << 5); R = (st >> 1) * 16 + swz / 64; C = (st & 1) * 32 + (swz % 64) / 2; }
__host__ __device__ __forceinline__ int perm32(int rho) { const int n = rho >> 4, i = rho & 15; return 8 * (i >> 2) + 4 * n + (i & 3); }

struct Unit { int pm, pn; };
struct Gemm { const bf16_t* A; const bf16_t* Bt; int M, N, K, ld; };

struct StaticOrder {
    int nM, nN, nwg, G, c;
    __host__ __device__ void init(int M, int N, int G_, int c_) { nM = M / BM; nN = N / BM; nwg = nM * nN; G = G_; c = c_; }
    __host__ __device__ bool next(int i, Unit& u) const {
        const long L = (long)i * G + c; if (L >= nwg) return false;
        int wgid = (int)L; { const int q = nwg / NXCD, r = nwg % NXCD, xcd = wgid % NXCD, off = wgid / NXCD; wgid = (xcd < r ? xcd * (q + 1) : r * (q + 1) + (xcd - r) * q) + off; }
        const int nig = WGM * nN, gid = wgid / nig, fm = gid * WGM, gsz = (nM - fm) < WGM ? (nM - fm) : WGM;
        u.pm = fm + ((wgid % nig) % gsz); u.pn = (wgid % nig) / gsz; return true;
    }
    __device__ __forceinline__ void a_ready(const Unit&) const {}
    __device__ __forceinline__ void done(const Unit&) const {}
};

__device__ __forceinline__ unsigned cvt_pk_bf16(float lo, float hi) { unsigned r; asm volatile("v_cvt_pk_bf16_f32 %0, %1, %2" : "=v"(r) : "v"(lo), "v"(hi)); return r; }
typedef float f32x2 __attribute__((ext_vector_type(2)));
template <class Epi, class Sched, bool ALIGN_EPI = false, bool SP2 = false>
__device__ __forceinline__ void gemm_phase(PG8_LAS unsigned char* lds, const Gemm g, const Sched& S, const Epi& E) {
    const int tid = threadIdx.x, wid = __builtin_amdgcn_readfirstlane(tid >> 6), lane = tid & 63, wr = wid >> 2, wc = wid & 3, fr = lane & 15, fq = lane >> 4;
    const int K = g.K, LD = g.ld, nt = K / BK;
    unsigned voffA[2], voffB[2];
#pragma unroll
    for (int i = 0; i < 2; ++i) { int R, C; stage_rc(tid * 16 + i * 8192, R, C); const int Rb = Epi::PERM ? ((R & ~31) + perm32(R & 31)) : R;
        voffA[i] = (unsigned)(R * LD + C) * 2u; voffB[i] = (unsigned)(Rb * LD + C) * 2u; }
    const size_t kstep = (size_t)(BK * 2);
    const size_t hstep = (size_t)HALF * LD * 2;
    const size_t tstep = 2 * hstep;
    const unsigned ldsw = (unsigned)wid * 1024u;
    const int aoff = lds_byte(wr * 64 + fr, fq * 8), boff = lds_byte(wc * 32 + fr, fq * 8);
#define PG8_SA(b, h) (((b) * 2 + (h)) * HTB)
#define PG8_SB(b, h) ((4 + (b) * 2 + (h)) * HTB)
#define PG8_STAGE(bufoff, gbase, voff) do { _Pragma("unroll") for (int _i = 0; _i < 2; ++_i) \
        __builtin_amdgcn_global_load_lds((const unsigned*)((const char*)(gbase) + (voff)[_i]), (PG8_LAS unsigned*)(lds + (bufoff) + ldsw + _i * 8192), 16, 0, 0); } while (0)
#define PG8_LDA(dst, b, h) do { _Pragma("unroll") for (int m = 0; m < 4; ++m) _Pragma("unroll") for (int k = 0; k < 2; ++k) dst[m][k] = *(const PG8_LAS bf16x8*)(lds + PG8_SA(b, h) + aoff + m * 2048 + k * 1024); } while (0)
#define PG8_LDB(dst, b, h) do { _Pragma("unroll") for (int n = 0; n < 2; ++n) _Pragma("unroll") for (int k = 0; k < 2; ++k) dst[n][k] = *(const PG8_LAS bf16x8*)(lds + PG8_SB(b, h) + boff + n * 2048 + k * 1024); } while (0)
#define PG8_MMA(ai, bj, At, Bt) do { __builtin_amdgcn_s_setprio(1); _Pragma("unroll") for (int m = 0; m < 4; ++m) _Pragma("unroll") for (int n = 0; n < 2; ++n) _Pragma("unroll") for (int k = 0; k < 2; ++k) \
        acc[ai][bj][m][n] = __builtin_amdgcn_mfma_f32_16x16x32_bf16(Bt[n][k], At[m][k], acc[ai][bj][m][n], 0, 0, 0); __builtin_amdgcn_s_setprio(0); } while (0)
#define PG8_WAIT_V(n) asm volatile("s_waitcnt vmcnt(" #n ")" ::: "memory")
#define PG8_WAIT_L(n) asm volatile("s_waitcnt lgkmcnt(" #n ")" ::: "memory")
#define PG8_BAR __builtin_amdgcn_s_barrier()
#define PG8_SCHED __builtin_amdgcn_sched_barrier(0)
    Unit cur, nxt; int ui = 0;
    if (!S.next(0, cur)) return;
    f32x4 acc[2][2][4][2];
#pragma unroll
    for (int a = 0; a < 2; ++a)
#pragma unroll
        for (int b = 0; b < 2; ++b)
#pragma unroll
            for (int m = 0; m < 4; ++m)
#pragma unroll
                for (int n = 0; n < 2; ++n) acc[a][b][m][n] = (f32x4){0.f, 0.f, 0.f, 0.f};
    bf16x8 At[4][2], B0[2][2], B1[2][2];
    const char* cA = (const char*)g.A + (size_t)cur.pm * tstep; const char* cB = (const char*)g.Bt + (size_t)cur.pn * tstep;
    S.a_ready(cur);
    if constexpr (SP2) {
        PG8_STAGE(PG8_SB(0, 0), cB, voffB); PG8_STAGE(PG8_SB(0, 1), cB + hstep, voffB); PG8_STAGE(PG8_SA(0, 0), cA, voffA); PG8_STAGE(PG8_SA(0, 1), cA + hstep, voffA);
        if (wr == 1) PG8_BAR;
        PG8_WAIT_V(2); PG8_BAR;
        PG8_STAGE(PG8_SB(1, 0), cB + kstep, voffB); PG8_STAGE(PG8_SA(1, 0), cA + kstep, voffA); PG8_STAGE(PG8_SB(1, 1), cB + hstep + kstep, voffB);
        PG8_WAIT_V(6); PG8_BAR;
    } else {
        PG8_STAGE(PG8_SB(0, 0), cB, voffB); PG8_STAGE(PG8_SA(0, 0), cA, voffA); PG8_STAGE(PG8_SB(0, 1), cB + hstep, voffB); PG8_STAGE(PG8_SA(0, 1), cA + hstep, voffA);
        if (wr == 1) PG8_BAR;
        PG8_WAIT_V(4); PG8_BAR;
        PG8_STAGE(PG8_SB(1, 0), cB + kstep, voffB); PG8_STAGE(PG8_SA(1, 0), cA + kstep, voffA); PG8_STAGE(PG8_SB(1, 1), cB + hstep + kstep, voffB);
        PG8_WAIT_V(6); PG8_BAR;
    }
    for (;;) {
        const bool has_next = S.next(ui + 1, nxt);
        const char* nA = has_next ? (const char*)g.A + (size_t)nxt.pm * tstep : cA; const char* nB = has_next ? (const char*)g.Bt + (size_t)nxt.pn * tstep : cB;
        for (int t = 0; t < nt; t += 2) {
            const bool last = (t == nt - 2);
            const char* a1 = cA + (size_t)(t + 1) * kstep;
            const char* a2 = last ? nA : cA + (size_t)(t + 2) * kstep; const char* b2 = last ? nB : cB + (size_t)(t + 2) * kstep;
            const char* a3 = a2 + kstep; const char* b3 = b2 + kstep;
            if (last && has_next) S.a_ready(nxt);
            if constexpr (SP2) {
            PG8_LDB(B0, 0, 0); PG8_LDB(B1, 0, 1); PG8_SCHED; PG8_LDA(At, 0, 0); PG8_STAGE(PG8_SA(1, 1), a1 + hstep, voffA);
            PG8_WAIT_V(8); PG8_WAIT_L(0); PG8_BAR; PG8_MMA(0, 0, At, B0); PG8_MMA(0, 1, At, B1); PG8_BAR; PG8_SCHED;
            PG8_LDA(At, 0, 1); PG8_STAGE(PG8_SB(0, 0), b2, voffB); PG8_STAGE(PG8_SB(0, 1), b2 + hstep, voffB); PG8_STAGE(PG8_SA(0, 0), a2, voffA);
            PG8_WAIT_V(8); PG8_WAIT_L(0); PG8_BAR; PG8_MMA(1, 0, At, B0); PG8_MMA(1, 1, At, B1); PG8_BAR; PG8_SCHED;
            PG8_LDB(B0, 1, 0); PG8_LDB(B1, 1, 1); PG8_SCHED; PG8_LDA(At, 1, 0); PG8_STAGE(PG8_SA(0, 1), a2 + hstep, voffA);
            PG8_WAIT_V(8); PG8_WAIT_L(0); PG8_BAR; PG8_MMA(0, 0, At, B0); PG8_MMA(0, 1, At, B1); PG8_BAR; PG8_SCHED;
            PG8_LDA(At, 1, 1); PG8_STAGE(PG8_SB(1, 0), b3, voffB); PG8_STAGE(PG8_SB(1, 1), b3 + hstep, voffB); PG8_STAGE(PG8_SA(1, 0), a3, voffA);
            PG8_WAIT_V(8); PG8_WAIT_L(0); PG8_BAR; PG8_MMA(1, 0, At, B0); PG8_MMA(1, 1, At, B1); PG8_BAR; PG8_SCHED;
            } else {
            PG8_LDB(B0, 0, 0); PG8_SCHED; PG8_LDA(At, 0, 0); PG8_STAGE(PG8_SA(1, 1), a1 + hstep, voffA);
            PG8_WAIT_L(8); PG8_BAR; PG8_WAIT_L(0); PG8_MMA(0, 0, At, B0); PG8_BAR; PG8_SCHED;
            PG8_LDB(B1, 0, 1); PG8_STAGE(PG8_SB(0, 0), b2, voffB);
            PG8_BAR; PG8_WAIT_L(0); PG8_MMA(0, 1, At, B1); PG8_BAR;
            PG8_LDA(At, 0, 1); PG8_STAGE(PG8_SA(0, 0), a2, voffA);
            PG8_BAR; PG8_WAIT_L(0); PG8_MMA(1, 0, At, B0); PG8_BAR; PG8_SCHED;
            PG8_STAGE(PG8_SB(0, 1), b2 + hstep, voffB);
            PG8_WAIT_V(6); PG8_BAR; PG8_MMA(1, 1, At, B1); PG8_BAR;
            PG8_LDB(B0, 1, 0); PG8_SCHED; PG8_LDA(At, 1, 0); PG8_STAGE(PG8_SA(0, 1), a2 + hstep, voffA);
            PG8_WAIT_L(8); PG8_BAR; PG8_WAIT_L(0); PG8_MMA(0, 0, At, B0); PG8_BAR; PG8_SCHED;
            PG8_LDB(B1, 1, 1); PG8_STAGE(PG8_SB(1, 0), b3, voffB);
            PG8_BAR; PG8_WAIT_L(0); PG8_MMA(0, 1, At, B1); PG8_BAR;
            PG8_LDA(At, 1, 1); PG8_STAGE(PG8_SA(1, 0), a3, voffA);
            PG8_BAR; PG8_WAIT_L(0); PG8_MMA(1, 0, At, B0); PG8_BAR; PG8_SCHED;
            PG8_STAGE(PG8_SB(1, 1), b3 + hstep, voffB);
            PG8_WAIT_V(6); PG8_BAR; PG8_MMA(1, 1, At, B1); PG8_BAR;
            }
        }
        if constexpr (ALIGN_EPI) { if (wr == 0) PG8_BAR; }
        if constexpr (!Epi::AFTER_DRAIN) { E(acc, cur, wr, wc, fr, fq); S.done(cur); }
        if (!has_next) break;
#pragma unroll
        for (int a = 0; a < 2; ++a)
#pragma unroll
            for (int b = 0; b < 2; ++b)
#pragma unroll
                for (int m = 0; m < 4; ++m)
#pragma unroll
                    for (int n = 0; n < 2; ++n) acc[a][b][m][n] = (f32x4){0.f, 0.f, 0.f, 0.f};
        cur = nxt; cA = nA; cB = nB; ++ui;
        if constexpr (ALIGN_EPI) { if (wr == 1) PG8_BAR; }
    }
    PG8_WAIT_V(0);
    if constexpr (!ALIGN_EPI) { if (wr == 0) PG8_BAR; }
    PG8_BAR;
    if constexpr (Epi::AFTER_DRAIN) { E.fused(acc, cur, wr, wc, fr, fq, lds, wid, lane); S.done(cur); }
#undef PG8_SA
#undef PG8_SB
#undef PG8_STAGE
#undef PG8_LDA
#undef PG8_LDB
#undef PG8_MMA
#undef PG8_WAIT_V
#undef PG8_WAIT_L
#undef PG8_BAR
#undef PG8_SCHED
}
}
#define LAS __attribute__((address_space(3)))
typedef unsigned short bf16_t;
typedef float f32x4 __attribute__((ext_vector_type(4)));
typedef unsigned u32x4 __attribute__((ext_vector_type(4)));
typedef unsigned u32x2 __attribute__((ext_vector_type(2)));

constexpr int DM = 1024, NB = 4, SEQ = 8192, CTXL = 256, NLAT = NB * SEQ, NCTX = NB * CTXL, MT = NLAT + NCTX;
constexpr int FF = 4096, ABIN = 2480, ABPAD = 2560;
constexpr int C_MQ = 0, C_MK = 512, C_MV = 1024, C_MO = 1536, C_MG = 2048, C_CQ = 2064, C_CKV = 2320, C_KR = 2448;
constexpr float EPS = 1e-6f;
constexpr size_t MiB = 1u << 20;
constexpr size_t WS_MOD = 1 * MiB;
constexpr size_t WS_XCTX = 2 * MiB;
constexpr size_t WS_WIN = 8 * MiB;
constexpr size_t WS_WUQ = 13 * MiB;
constexpr size_t WS_WUKV = 13 * MiB + 512 * 1024;
constexpr size_t WS_WOUT = 14 * MiB;
constexpr size_t WS_WNA = 16 * MiB;
constexpr size_t WS_WNAOUT = 22 * MiB;
constexpr size_t WS_W1 = 24 * MiB;
constexpr size_t WS_W2 = 40 * MiB;
constexpr size_t WS_XN = 56 * MiB;
constexpr size_t WS_Y = 122 * MiB;
constexpr size_t WS_XR = WS_Y;
constexpr size_t WS_CKVN = WS_Y;
constexpr size_t WS_BIG = 188 * MiB;
constexpr size_t WS_PROJ = WS_BIG;
constexpr size_t WS_QA = 353 * MiB;
constexpr size_t WS_KA = 403 * MiB;
constexpr size_t WS_VT = 453 * MiB;
constexpr size_t WS_CQN = 487 * MiB;
constexpr size_t WS_CKVN_UNUSED = 504 * MiB;
constexpr size_t WS_ST = 353 * MiB;
constexpr size_t WS_SC = 1 * MiB + 512 * 1024;
constexpr size_t WS_MS = WS_SC + 64 * 1024;
constexpr int ST_SLOT = 129 * 128;
constexpr size_t WS_BAR = 1 * MiB + 768 * 1024;
constexpr size_t WS_VT1 = 390 * MiB;
constexpr size_t WS_END = 504 * MiB;
static_assert(WS_ST + (size_t)2 * 16 * 132 * ST_SLOT * 2 <= 487 * MiB, "ST fits in the QA|KA|VT span");
constexpr int LDS_BYTES = 147456;

struct P { const float* in[22]; float* out; unsigned char* ws; int ph_lo, ph_hi; };
enum { I_X = 0, I_C, I_CTX, I_CCTX, I_ADAW, I_ADAB, I_N1G, I_N2G, I_W1, I_W2, I_ABWIN, I_GATEB, I_MNG, I_QNG, I_KVNG, I_WUQ, I_WUKV, I_ABWOUT, I_NAWIN, I_RELB, I_NAWOUT, I_FNG };

__device__ __forceinline__ float bf2f(unsigned h) { return __uint_as_float(h << 16); }
__device__ __forceinline__ float bflo(unsigned w) { return __uint_as_float(w << 16); }
__device__ __forceinline__ float bfhi(unsigned w) { return __uint_as_float(w & 0xffff0000u); }
__device__ __forceinline__ unsigned f2bf(float f) { unsigned u = __float_as_uint(f); return (u + 0x7fffu + ((u >> 16) & 1u)) >> 16; }
__device__ __forceinline__ unsigned pk2(float lo, float hi) { return f2bf(lo) | (f2bf(hi) << 16); }
__device__ __forceinline__ float wave_sum(float v) {
#pragma unroll
    for (int o = 1; o < 64; o <<= 1) v += __shfl_xor(v, o);
    return v;
}
#define LDS_WAIT() asm volatile("s_waitcnt lgkmcnt(0)" ::: "memory")

template <int ACT  > struct EpiBf16 {
    static constexpr bool PERM = true, AFTER_DRAIN = false;
    bf16_t* O; int ldc;
    __device__ __forceinline__ void operator()(const pg8::f32x4 (&acc)[2][2][4][2], const pg8::Unit& u, int wr, int wc, int fr, int fq) const {
        const int row0 = u.pm * 256 + wr * 64 + fr, col0 = u.pn * 256 + wc * 32 + 8 * fq;
#pragma unroll
        for (int ai = 0; ai < 2; ++ai)
#pragma unroll
            for (int m = 0; m < 4; ++m) { bf16_t* rowp = O + (size_t)(row0 + ai * 128 + m * 16) * ldc + col0;
#pragma unroll
                for (int bj = 0; bj < 2; ++bj) { pg8::f32x4 v0 = acc[ai][bj][m][0], v1 = acc[ai][bj][m][1];
                    if (ACT == 2) {
#pragma unroll
                        for (int e = 0; e < 4; ++e) { float a = fmaxf(v0[e], 0.f), b = fmaxf(v1[e], 0.f); v0[e] = a * a; v1[e] = b * b; } }
                    u32x4 w; w.x = pg8::cvt_pk_bf16(v0[0], v0[1]); w.y = pg8::cvt_pk_bf16(v0[2], v0[3]); w.z = pg8::cvt_pk_bf16(v1[0], v1[1]); w.w = pg8::cvt_pk_bf16(v1[2], v1[3]);
                    if (ACT == 2) __builtin_nontemporal_store(w, (u32x4*)(rowp + bj * 128));
                    else *(u32x4*)(rowp + bj * 128) = w; } }
    }
};
struct EpiRes {
    static constexpr bool PERM = true, AFTER_DRAIN = false;
    const float* in_lat; const float* in_ctx; float* out_lat; float* out_ctx; const float* gate;
    __device__ __forceinline__ void operator()(const pg8::f32x4 (&acc)[2][2][4][2], const pg8::Unit& u, int wr, int wc, int fr, int fq) const {
        const int row0 = u.pm * 256 + wr * 64 + fr, col0 = u.pn * 256 + wc * 32 + 8 * fq;
#pragma unroll
        for (int ai = 0; ai < 2; ++ai)
#pragma unroll
            for (int m = 0; m < 4; ++m) { const int row = row0 + ai * 128 + m * 16;
                const float* ip; float* op; int mr;
                if (row < NLAT) { ip = in_lat + (size_t)row * DM; op = out_lat + (size_t)row * DM; mr = row >> 13; }
                else { ip = in_ctx + (size_t)(row - NLAT) * DM; op = out_ctx + (size_t)(row - NLAT) * DM; mr = 4; }
                const float* gp = gate + mr * 6144;
#pragma unroll
                for (int bj = 0; bj < 2; ++bj) { const int c = col0 + bj * 128;
                    const f32x4 g0 = *(const f32x4*)(gp + c), g1 = *(const f32x4*)(gp + c + 4);
                    const f32x4 x0 = *(const f32x4*)(ip + c), x1 = *(const f32x4*)(ip + c + 4);
                    *(f32x4*)(op + c) = x0 + g0 * acc[ai][bj][m][0]; *(f32x4*)(op + c + 4) = x1 + g1 * acc[ai][bj][m][1]; } }
    }
};

struct EpiRes16 {
    static constexpr bool PERM = true, AFTER_DRAIN = false;
    const float* in32; bf16_t* xr; const float* gate;
    __device__ __forceinline__ void operator()(const pg8::f32x4 (&acc)[2][2][4][2], const pg8::Unit& u, int wr, int wc, int fr, int fq) const {
        const int row0 = u.pm * 256 + wr * 64 + fr, col0 = u.pn * 256 + wc * 32 + 8 * fq;
#pragma unroll
        for (int ai = 0; ai < 2; ++ai)
#pragma unroll
            for (int m = 0; m < 4; ++m) { const int row = row0 + ai * 128 + m * 16; const float* gp = gate + (row >> 13) * 6144; bf16_t* xp = xr + (size_t)row * DM;
#pragma unroll
                for (int bj = 0; bj < 2; ++bj) { const int c = col0 + bj * 128;
                    f32x4 x0, x1;
                    if (in32) { x0 = *(const f32x4*)(in32 + (size_t)row * DM + c); x1 = *(const f32x4*)(in32 + (size_t)row * DM + c + 4); }
                    else { const u32x4 w = *(const u32x4*)(xp + c); x0 = (f32x4){bflo(w.x), bfhi(w.x), bflo(w.y), bfhi(w.y)}; x1 = (f32x4){bflo(w.z), bfhi(w.z), bflo(w.w), bfhi(w.w)}; }
                    const f32x4 v0 = x0 + *(const f32x4*)(gp + c) * acc[ai][bj][m][0], v1 = x1 + *(const f32x4*)(gp + c + 4) * acc[ai][bj][m][1];
                    u32x4 o; o.x = pk2(v0.x, v0.y); o.y = pk2(v0.z, v0.w); o.z = pk2(v1.x, v1.y); o.w = pk2(v1.z, v1.w);
                    *(u32x4*)(xp + c) = o; } }
    }
};
__device__ __forceinline__ void transpose_item(const float* W, int K, int N, int Npad, bf16_t* WT, LAS float* scr, int item, int lane) {
    const int nblk = Npad / 32, kb = item / nblk, nb = item % nblk, k0 = 64 * kb, n0 = 32 * nb;
    const int kr = lane >> 3, n4 = 4 * (lane & 7); const bool inb = (n0 + n4) < N;
    f32x4 tv[8];
#pragma unroll
    for (int i = 0; i < 8; ++i) tv[i] = inb ? *(const f32x4*)(W + (size_t)(k0 + 8 * i + kr) * N + n0 + n4) : (f32x4){0.f, 0.f, 0.f, 0.f};
#pragma unroll
    for (int i = 0; i < 8; ++i) { LAS float* d = scr + (8 * i + kr) * 33 + n4; d[0] = tv[i].x; d[1] = tv[i].y; d[2] = tv[i].z; d[3] = tv[i].w; }
    LDS_WAIT(); asm volatile("" ::: "memory");
    const int c = lane & 7;
#pragma unroll
    for (int j = 0; j < 4; ++j) { const int nn = (lane >> 3) + 8 * j; const LAS float* s = scr + (8 * c) * 33 + nn;
        u32x4 o; o.x = pk2(s[0 * 33], s[1 * 33]); o.y = pk2(s[2 * 33], s[3 * 33]); o.z = pk2(s[4 * 33], s[5 * 33]); o.w = pk2(s[6 * 33], s[7 * 33]);
        *(u32x4*)(WT + (size_t)(n0 + nn) * K + k0 + 8 * c) = o; }
    LDS_WAIT(); asm volatile("" ::: "memory");
}
__device__ __forceinline__ void p0_phase(const P& p, LAS unsigned char* lds, int bid, int G, int tid, int wave, int lane) {
    {
        LAS float* sil = (LAS float*)lds;
        LAS float* red = sil + 5 * 1024;
        if (bid < 192) {
            for (int i = tid; i < 5 * 1024; i += 512) { const int r = i >> 10, k = i & 1023; const float x = (r < 4) ? p.in[I_C][r * 1024 + k] : p.in[I_CCTX][k]; sil[i] = x / (1.f + expf(-x)); }
            __syncthreads();
            for (int it = bid; it < 192; it += G) {
                const int l = it / 96, cb = it % 96, col = cb * 64 + lane;
                const float* w = p.in[I_ADAW] + (size_t)l * 1024 * 6144 + col;
                float a0 = 0.f, a1 = 0.f, a2 = 0.f, a3 = 0.f, a4 = 0.f;
#pragma unroll 32
                for (int k = wave * 128; k < wave * 128 + 128; ++k) { const float ww = w[(size_t)k * 6144];
                    a0 += sil[k] * ww; a1 += sil[1024 + k] * ww; a2 += sil[2048 + k] * ww; a3 += sil[3072 + k] * ww; a4 += sil[4096 + k] * ww; }
                red[(wave * 5 + 0) * 64 + lane] = a0; red[(wave * 5 + 1) * 64 + lane] = a1; red[(wave * 5 + 2) * 64 + lane] = a2; red[(wave * 5 + 3) * 64 + lane] = a3; red[(wave * 5 + 4) * 64 + lane] = a4;
                __syncthreads();
                if (tid < 320) { const int r = tid >> 6, cl = tid & 63; float s = p.in[I_ADAB][l * 6144 + cb * 64 + cl];
#pragma unroll
                    for (int wv = 0; wv < 8; ++wv) s += red[(wv * 5 + r) * 64 + cl];
                    ((float*)(p.ws + WS_MOD))[(l * 5 + r) * 6144 + cb * 64 + cl] = s; }
                __syncthreads();
            }
        }
        __syncthreads();
    }
    {
        LAS float* scr = (LAS float*)(lds + wave * 16384);
        const int gw = bid * 8 + wave, NGW = G * 8;
        constexpr int I0 = 16 * 80, I1 = 4 * 24, I2 = 2 * 32, I3 = 16 * 32, I4 = 16 * 96, I5 = 16 * 32, I6 = 16 * 128, I8 = 64 * 32;
        constexpr int NIT = I0 + I1 + I2 + I3 + I4 + I5 + 2 * I6 + 2 * I8;
        for (int it = gw; it < NIT; it += NGW) {
            int r = it;
            if (r < I0) { transpose_item(p.in[I_ABWIN], 1024, ABIN, ABPAD, (bf16_t*)(p.ws + WS_WIN), scr, r, lane); continue; } r -= I0;
            if (r < I1) { transpose_item(p.in[I_WUQ], 256, 768, 768, (bf16_t*)(p.ws + WS_WUQ), scr, r, lane); continue; } r -= I1;
            if (r < I2) { transpose_item(p.in[I_WUKV], 128, 1024, 1024, (bf16_t*)(p.ws + WS_WUKV), scr, r, lane); continue; } r -= I2;
            if (r < I3) { transpose_item(p.in[I_ABWOUT], 1024, 1024, 1024, (bf16_t*)(p.ws + WS_WOUT), scr, r, lane); continue; } r -= I3;
            if (r < I4) { transpose_item(p.in[I_NAWIN], 1024, 3072, 3072, (bf16_t*)(p.ws + WS_WNA), scr, r, lane); continue; } r -= I4;
            if (r < I5) { transpose_item(p.in[I_NAWOUT], 1024, 1024, 1024, (bf16_t*)(p.ws + WS_WNAOUT), scr, r, lane); continue; } r -= I5;
            if (r < 2 * I6) { const int l = r / I6; transpose_item(p.in[I_W1] + (size_t)l * 1024 * 4096, 1024, 4096, 4096, (bf16_t*)(p.ws + WS_W1) + (size_t)l * 4096 * 1024, scr, r % I6, lane); continue; } r -= 2 * I6;
            { const int l = r / I8; transpose_item(p.in[I_W2] + (size_t)l * 4096 * 1024, 4096, 1024, 1024, (bf16_t*)(p.ws + WS_W2) + (size_t)l * 1024 * 4096, scr, r % I8, lane); }
        }
    }
}

__device__ __forceinline__ void modulate_phase(const float* src_lat, const float* src_ctx, int nrows, const float* g, const float* modl, int off_sh, int off_sc, bf16_t* XN, int gw, int NGW, int lane,
                                               const float* part = nullptr, int ns = 0, const float* pgate = nullptr, float* xback = nullptr, const bf16_t* src_lat16 = nullptr) {
    for (int row0 = gw; row0 < nrows; row0 += 2 * NGW) {
        f32x4 v[2][4]; float s[2] = {0.f, 0.f};
#pragma unroll
        for (int r = 0; r < 2; ++r) { const int row = min(row0 + r * NGW, nrows - 1);
            if (src_lat16 && row < NLAT) { const u32x2* x16 = (const u32x2*)(src_lat16 + (size_t)row * DM) + lane;
#pragma unroll
                for (int j = 0; j < 4; ++j) { const u32x2 w = __builtin_nontemporal_load(x16 + 64 * j); v[r][j] = (f32x4){bflo(w.x), bfhi(w.x), bflo(w.y), bfhi(w.y)}; } }
            else { const float* src = (row < NLAT) ? src_lat + (size_t)row * DM : src_ctx + (size_t)(row - NLAT) * DM; const f32x4* xr = (const f32x4*)src + lane;
#pragma unroll
                for (int j = 0; j < 4; ++j) v[r][j] = __builtin_nontemporal_load(xr + 64 * j); } }
#pragma unroll
        for (int r = 0; r < 2; ++r) { const int row = row0 + r * NGW;
            if (part && row >= NLAT && row < nrows) {
                const f32x4* pr = (const f32x4*)(part + (size_t)(row - NLAT) * DM) + lane; const f32x4* pg = (const f32x4*)pgate + lane;
#pragma unroll
                for (int j = 0; j < 4; ++j) { f32x4 a = pr[64 * j];
                    for (int q = 1; q < ns; ++q) a += pr[(size_t)q * (NCTX * DM / 4) + 64 * j];
                    v[r][j] += pg[64 * j] * a; }
                if (xback) { f32x4* xb = (f32x4*)(xback + (size_t)(row - NLAT) * DM) + lane;
#pragma unroll
                    for (int j = 0; j < 4; ++j) xb[64 * j] = v[r][j]; }
            }
#pragma unroll
            for (int j = 0; j < 4; ++j) s[r] += (v[r][j].x * v[r][j].x + v[r][j].y * v[r][j].y) + (v[r][j].z * v[r][j].z + v[r][j].w * v[r][j].w); }
        const float rs0 = rsqrtf(wave_sum(s[0]) * (1.f / DM) + EPS), rs1 = rsqrtf(wave_sum(s[1]) * (1.f / DM) + EPS);
#pragma unroll
        for (int r = 0; r < 2; ++r) { const int row = row0 + r * NGW;
            if (row < nrows) { const int mr = (row < NLAT) ? (row >> 13) : 4; const float rstd = r ? rs1 : rs0;
                const f32x4* g4 = (const f32x4*)g + lane; const f32x4* sh4 = (const f32x4*)(modl + mr * 6144 + off_sh) + lane; const f32x4* sc4 = (const f32x4*)(modl + mr * 6144 + off_sc) + lane;
                u32x2* o8 = (u32x2*)(XN + (size_t)row * DM) + lane;
#pragma unroll
                for (int j = 0; j < 4; ++j) { const f32x4 gg = g4[64 * j], sh = sh4[64 * j], sc = sc4[64 * j];
                    const f32x4 y = (v[r][j] * rstd * gg) * (sc + 1.f) + sh; u32x2 w; w.x = pk2(y.x, y.y); w.y = pk2(y.z, y.w); o8[64 * j] = w; } } }
    }
}

__device__ __forceinline__ float rope_angle(int t, int j) {
    const float pos = (j < 8) ? (float)(t >> 6) : (float)(t & 63);
    const float fr = powf(10000.0f, -(float)(j & 7) / 8.0f);
    return pos * fr;
}

__device__ __forceinline__ float sum16(float v) { v += __shfl_xor(v, 1); v += __shfl_xor(v, 2); v += __shfl_xor(v, 4); v += __shfl_xor(v, 8); return v; }
__device__ __forceinline__ void p3a_phase(const P& p, int gw, int NGW, int lane) {
    const bf16_t* PROJ = (const bf16_t*)(p.ws + WS_PROJ);
    bf16_t* CQN = (bf16_t*)(p.ws + WS_CQN); bf16_t* CKVN = (bf16_t*)(p.ws + WS_CKVN); bf16_t* KA = (bf16_t*)(p.ws + WS_KA);
    const int l16 = lane & 15, sub = lane >> 4;
    f32x4 gq[4]; f32x4 gk[2];
#pragma unroll
    for (int i = 0; i < 4; ++i) gq[i] = *((const f32x4*)p.in[I_QNG] + 4 * l16 + i);
#pragma unroll
    for (int i = 0; i < 2; ++i) gk[i] = *((const f32x4*)p.in[I_KVNG] + 2 * l16 + i);
    for (int rg = gw; rg < MT / 4; rg += NGW) {
        const int row = 4 * rg + sub;
        const bf16_t* pr = PROJ + (size_t)row * ABPAD;
        { const u32x4 w0 = *(const u32x4*)(pr + C_CQ + 16 * l16), w1 = *(const u32x4*)(pr + C_CQ + 16 * l16 + 8);
          float v[16] = {bflo(w0.x), bfhi(w0.x), bflo(w0.y), bfhi(w0.y), bflo(w0.z), bfhi(w0.z), bflo(w0.w), bfhi(w0.w), bflo(w1.x), bfhi(w1.x), bflo(w1.y), bfhi(w1.y), bflo(w1.z), bfhi(w1.z), bflo(w1.w), bfhi(w1.w)};
          float ss = 0.f;
#pragma unroll
          for (int i = 0; i < 16; ++i) ss += v[i] * v[i];
          const float rstd = rsqrtf(sum16(ss) * (1.f / 256.f) + EPS);
          u32x4 o0, o1;
          o0.x = pk2(v[0] * rstd * gq[0].x, v[1] * rstd * gq[0].y); o0.y = pk2(v[2] * rstd * gq[0].z, v[3] * rstd * gq[0].w); o0.z = pk2(v[4] * rstd * gq[1].x, v[5] * rstd * gq[1].y); o0.w = pk2(v[6] * rstd * gq[1].z, v[7] * rstd * gq[1].w);
          o1.x = pk2(v[8] * rstd * gq[2].x, v[9] * rstd * gq[2].y); o1.y = pk2(v[10] * rstd * gq[2].z, v[11] * rstd * gq[2].w); o1.z = pk2(v[12] * rstd * gq[3].x, v[13] * rstd * gq[3].y); o1.w = pk2(v[14] * rstd * gq[3].z, v[15] * rstd * gq[3].w);
          *(u32x4*)(CQN + (size_t)row * 256 + 16 * l16) = o0; *(u32x4*)(CQN + (size_t)row * 256 + 16 * l16 + 8) = o1; }
        { const u32x4 w = *(const u32x4*)(pr + C_CKV + 8 * l16);
          float v[8] = {bflo(w.x), bfhi(w.x), bflo(w.y), bfhi(w.y), bflo(w.z), bfhi(w.z), bflo(w.w), bfhi(w.w)};
          float ss = 0.f;
#pragma unroll
          for (int i = 0; i < 8; ++i) ss += v[i] * v[i];
          const float rstd = rsqrtf(sum16(ss) * (1.f / 128.f) + EPS);
          u32x4 o; o.x = pk2(v[0] * rstd * gk[0].x, v[1] * rstd * gk[0].y); o.y = pk2(v[2] * rstd * gk[0].z, v[3] * rstd * gk[0].w); o.z = pk2(v[4] * rstd * gk[1].x, v[5] * rstd * gk[1].y); o.w = pk2(v[6] * rstd * gk[1].z, v[7] * rstd * gk[1].w);
          *(u32x4*)(CKVN + (size_t)row * 128 + 8 * l16) = o; }
        { float xa = bf2f(pr[C_KR + l16]), xb = bf2f(pr[C_KR + 16 + l16]);
          if (row < NLAT) { const float ang = rope_angle(row & 8191, l16); const float cs = cosf(ang), sn = sinf(ang); const float ya = xa * cs - xb * sn, yb = xa * sn + xb * cs; xa = ya; xb = yb; }
          const bf16_t ba = (bf16_t)f2bf(xa), bb = (bf16_t)f2bf(xb);
#pragma unroll
          for (int hh = 0; hh < 8; ++hh) { KA[(size_t)row * 768 + hh * 96 + 64 + l16] = ba; KA[(size_t)row * 768 + hh * 96 + 80 + l16] = bb; } }
    }
}

__device__ __forceinline__ float dot8(const u32x4 w, const float* q) {
    return (q[0] * bflo(w.x) + q[1] * bfhi(w.x)) + (q[2] * bflo(w.y) + q[3] * bfhi(w.y)) + (q[4] * bflo(w.z) + q[5] * bfhi(w.z)) + (q[6] * bflo(w.w) + q[7] * bfhi(w.w));
}
__device__ __forceinline__ void axpy8(float* o, float pw, const u32x4 w) {
    o[0] += pw * bflo(w.x); o[1] += pw * bfhi(w.x); o[2] += pw * bflo(w.y); o[3] += pw * bfhi(w.y); o[4] += pw * bflo(w.z); o[5] += pw * bfhi(w.z); o[6] += pw * bflo(w.w); o[7] += pw * bfhi(w.w);
}

struct EpiKV {
    static constexpr bool PERM = true, AFTER_DRAIN = false;
    bf16_t* KA; bf16_t* VT;
    __device__ __forceinline__ void operator()(const pg8::f32x4 (&acc)[2][2][4][2], const pg8::Unit& u, int wr, int wc, int fr, int fq) const {
        const int row0 = u.pm * 256 + wr * 64 + fr;
        const int j0 = wc * 32 + 8 * fq;
#pragma unroll
        for (int ai = 0; ai < 2; ++ai)
#pragma unroll
            for (int m = 0; m < 4; ++m) { const int row = row0 + ai * 128 + m * 16;
                int b, key; if (row < NLAT) { b = row >> 13; key = row & 8191; } else { b = (row - NLAT) >> 8; key = SEQ + ((row - NLAT) & 255); }
                { const int q4 = (key >> 2) & 3; key = (key & ~12) | ((((q4 & 1) << 1) | (q4 >> 1)) << 2); }
#pragma unroll
                for (int bj = 0; bj < 2; ++bj) { const int head = u.pn * 2 + bj; const pg8::f32x4 v0 = acc[ai][bj][m][0], v1 = acc[ai][bj][m][1];
                    if (j0 < 64) { u32x4 w; w.x = pk2(v0[0], v0[1]); w.y = pk2(v0[2], v0[3]); w.z = pk2(v1[0], v1[1]); w.w = pk2(v1[2], v1[3]);
                        *(u32x4*)(KA + (size_t)row * 768 + head * 96 + j0) = w; }
                    else { bf16_t* vp = VT + ((size_t)(b * 8 + head) * 64 + (j0 - 64)) * 8448 + key;
#pragma unroll
                        for (int e = 0; e < 4; ++e) { vp[(size_t)e * 8448] = (bf16_t)f2bf(v0[e]); vp[(size_t)(e + 4) * 8448] = (bf16_t)f2bf(v1[e]); } } } }
    }
};

typedef float f32x16 __attribute__((ext_vector_type(16)));
typedef short bf16x8 __attribute__((ext_vector_type(8)));
typedef float f32x2_t __attribute__((ext_vector_type(2)));
typedef __bf16 bf16x2_t __attribute__((ext_vector_type(2)));
__device__ __forceinline__ unsigned cvtpk(float lo, float hi) { f32x2_t v = {lo, hi}; bf16x2_t b = __builtin_convertvector(v, bf16x2_t); return __builtin_bit_cast(unsigned, b); }
__device__ __forceinline__ float xhalf_max(float v) { auto rr = __builtin_amdgcn_permlane32_swap(__float_as_uint(v), __float_as_uint(v), false, false); return fmaxf(__uint_as_float(rr[0]), __uint_as_float(rr[1])); }
__device__ __forceinline__ float xhalf_sum(float v) { auto rr = __builtin_amdgcn_permlane32_swap(__float_as_uint(v), __float_as_uint(v), false, false); return __uint_as_float(rr[0]) + __uint_as_float(rr[1]); }
constexpr int MLA_KP = 208, MLA_VP = 144, MLA_KB = 64 * MLA_KP, MLA_VB = 64 * MLA_VP, MLA_BUF = MLA_KB + MLA_VB;
__device__ __forceinline__ int mla_tile_row0(int b, int kt) { return kt < 128 ? b * SEQ + 64 * kt : NLAT + b * CTXL + 64 * (kt - 128); }
template <int MF> __device__ __forceinline__ void mla_attn_phase(const P& p, LAS unsigned char* lds, int bid, int G, int tid, int wave, int lane) {
    const bf16_t* QA = (const bf16_t*)(p.ws + WS_QA); const bf16_t* KA = (const bf16_t*)(p.ws + WS_KA); const bf16_t* VT = (const bf16_t*)(p.ws + WS_VT);
    bf16_t* Y = MF ? (bf16_t*)(p.ws + WS_XN) : (bf16_t*)p.out;
    const int vcu = (G % 8 == 0) ? (bid % 8) * (G / 8) + bid / 8 : bid;
    const int r32 = lane & 31, hi = lane >> 5;
    const int kr0 = tid / 12, kc0 = tid % 12, kr1 = (tid + 512) / 12, kc1 = (tid + 512) % 12, vd = tid >> 3, vc = tid & 7;
    for (int u = vcu; u < 1056; u += G) {
        int b, h, qrow0, kt0; const int kt1 = 132;
        if (u < 1024) { const int bh = u >> 5; b = bh >> 3; h = bh & 7; qrow0 = b * SEQ + (u & 31) * 256; kt0 = 0; }
        else { const int bh = u - 1024; b = bh >> 3; h = bh & 7; qrow0 = NLAT + b * CTXL; kt0 = 128; }
        const int qrow = qrow0 + wave * 32 + r32;
        bf16x8 qf[6];
        { float qv[6][8];
#pragma unroll
          for (int ks = 0; ks < 6; ++ks) { const u32x4 w = *(const u32x4*)(QA + (size_t)qrow * 768 + h * 96 + 16 * ks + 8 * hi);
              qv[ks][0] = bflo(w.x); qv[ks][1] = bfhi(w.x); qv[ks][2] = bflo(w.y); qv[ks][3] = bfhi(w.y); qv[ks][4] = bflo(w.z); qv[ks][5] = bfhi(w.z); qv[ks][6] = bflo(w.w); qv[ks][7] = bfhi(w.w); }
          if (u < 1024) { const int t = qrow & 8191;
#pragma unroll
              for (int j = 0; j < 8; ++j) { const float ang = rope_angle(t, 8 * hi + j); const float cs = cosf(ang), sn = sinf(ang);
                  const float xa = qv[4][j], xb = qv[5][j]; qv[4][j] = xa * cs - xb * sn; qv[5][j] = xa * sn + xb * cs; } }
          const float sc = 0.10206207261596577f * 1.4426950408889634f;
#pragma unroll
          for (int ks = 0; ks < 6; ++ks) { u32x4 w; w.x = pk2(qv[ks][0] * sc, qv[ks][1] * sc); w.y = pk2(qv[ks][2] * sc, qv[ks][3] * sc); w.z = pk2(qv[ks][4] * sc, qv[ks][5] * sc); w.w = pk2(qv[ks][6] * sc, qv[ks][7] * sc);
              qf[ks] = __builtin_bit_cast(bf16x8, w); } }
        const bf16_t* VTh = VT + (size_t)(b * 8 + h) * 64 * 8448;
        const int pc1 = wave + 8, pc2 = min(wave + 16, 21);
        size_t dsrc0, dsrc1, dsrc2; bool v1;
        { const int s0_ = 64 * wave + lane; dsrc0 = (size_t)(s0_ / 13) * 768 + h * 96 + min(s0_ % 13, 11) * 8;
          v1 = pc1 >= 13;
          if (!v1) { const int s1_ = 64 * pc1 + lane; dsrc1 = (size_t)(s1_ / 13) * 768 + h * 96 + min(s1_ % 13, 11) * 8; }
          else { const int s1_ = 64 * (pc1 - 13) + lane; dsrc1 = (size_t)(s1_ / 9) * 8448 + min(s1_ % 9, 7) * 8; }
          const int s2_ = 64 * (pc2 - 13) + lane; dsrc2 = (size_t)(s2_ / 9) * 8448 + min(s2_ % 9, 7) * 8; }
#define MLA_DMA(ST, KTL) do { const int ktl_ = (KTL); const bf16_t* kb_ = KA + (size_t)mla_tile_row0(b, ktl_) * 768; const bf16_t* vb_ = VTh + 64 * ktl_; LAS unsigned char* sb_ = lds + (ST) * MLA_BUF; \
            __builtin_amdgcn_global_load_lds((const unsigned*)(kb_ + dsrc0), (LAS unsigned*)(sb_ + wave * 1024), 16, 0, 0); \
            __builtin_amdgcn_global_load_lds((const unsigned*)((v1 ? vb_ : kb_) + dsrc1), (LAS unsigned*)(sb_ + pc1 * 1024), 16, 0, 0); \
            __builtin_amdgcn_global_load_lds((const unsigned*)(vb_ + dsrc2), (LAS unsigned*)(sb_ + pc2 * 1024), 16, 0, 0); } while (0)
        MLA_DMA(0, kt0); MLA_DMA(1, min(kt0 + 1, kt1 - 1)); MLA_DMA(2, min(kt0 + 2, kt1 - 1));
        asm volatile("s_waitcnt vmcnt(3)\n\ts_barrier" ::: "memory");
        f32x16 o0, o1, cA0, cA1, cB0, cB1; const f32x16 z16 = {0.f, 0.f, 0.f, 0.f, 0.f, 0.f, 0.f, 0.f, 0.f, 0.f, 0.f, 0.f, 0.f, 0.f, 0.f, 0.f};
#pragma unroll
        for (int i = 0; i < 16; ++i) { o0[i] = 0.f; o1[i] = 0.f; }
#define MLA_MFMA(a, bq, c) __builtin_amdgcn_mfma_f32_32x32x16_bf16((a), (bq), (c), 0, 0, 0)
#define MLA_QK(P0, P1, ST) do { const LAS unsigned char* Kb_ = lds + (ST) * MLA_BUF + r32 * MLA_KP + hi * 16; \
            _Pragma("unroll") for (int ks = 0; ks < 6; ++ks) { const bf16x8 k0_ = *(const LAS bf16x8*)(Kb_ + ks * 32); const bf16x8 k1_ = *(const LAS bf16x8*)(Kb_ + 32 * MLA_KP + ks * 32); \
                if (ks == 0) { P0 = MLA_MFMA(k0_, qf[0], z16); P1 = MLA_MFMA(k1_, qf[0], z16); } else { P0 = MLA_MFMA(k0_, qf[ks], P0); P1 = MLA_MFMA(k1_, qf[ks], P1); } } } while (0)
        float m, l = 0.f;
        { MLA_QK(cA0, cA1, 0);
          float rm = fmaxf(cA0[0], cA1[0]);
#pragma unroll
          for (int i = 1; i < 16; ++i) rm = fmaxf(rm, fmaxf(cA0[i], cA1[i]));
          rm = xhalf_max(rm); m = (fabsf(rm) > 16.f) ? rm : 0.f;
          if (__any(m != 0.f)) {
#pragma unroll
              for (int i = 0; i < 16; ++i) { cA0[i] -= m; cA1[i] -= m; } } }
        int s_cur = 0, s_nxt = 1, s_lnd = 2, s_pre = 3;
#define MLA_STEP(C0, C1, N0, N1, KT) do { const int kt_ = (KT); \
            MLA_DMA(s_pre, min(kt_ + 3, kt1 - 1)); \
            if (!(MF & 4)) MLA_QK(N0, N1, s_nxt); \
            float ls = 0.f; \
            if (!(MF & 1)) { _Pragma("unroll") for (int i = 0; i < 16; ++i) { C0[i] = __builtin_amdgcn_exp2f(C0[i]); C1[i] = __builtin_amdgcn_exp2f(C1[i]); ls += C0[i] + C1[i]; } } else ls = 1.f; \
            const LAS unsigned char* Vb = lds + s_cur * MLA_BUF + MLA_KB; \
            if (!(MF & 2)) _Pragma("unroll") for (int kh = 0; kh < 2; ++kh) \
            _Pragma("unroll") for (int s2 = 0; s2 < 2; ++s2) { const int kb = (32 * kh + 16 * s2 + 8 * hi) * 2; \
                u32x4 w; if (kh == 0) { w.x = cvtpk(C0[8 * s2], C0[8 * s2 + 1]); w.y = cvtpk(C0[8 * s2 + 2], C0[8 * s2 + 3]); w.z = cvtpk(C0[8 * s2 + 4], C0[8 * s2 + 5]); w.w = cvtpk(C0[8 * s2 + 6], C0[8 * s2 + 7]); } \
                else { w.x = cvtpk(C1[8 * s2], C1[8 * s2 + 1]); w.y = cvtpk(C1[8 * s2 + 2], C1[8 * s2 + 3]); w.z = cvtpk(C1[8 * s2 + 4], C1[8 * s2 + 5]); w.w = cvtpk(C1[8 * s2 + 6], C1[8 * s2 + 7]); } \
                const bf16x8 pf_ = __builtin_bit_cast(bf16x8, w); \
                const bf16x8 va_ = *(const LAS bf16x8*)(Vb + r32 * MLA_VP + kb), vb_ = *(const LAS bf16x8*)(Vb + (32 + r32) * MLA_VP + kb); \
                o0 = MLA_MFMA(va_, pf_, o0); o1 = MLA_MFMA(vb_, pf_, o1); } \
            l += ls; const float lsx = xhalf_sum(ls); \
            asm volatile("s_waitcnt vmcnt(3) lgkmcnt(0)\n\ts_barrier" ::: "memory");       \
            { const int t_ = s_cur; s_cur = s_nxt; s_nxt = s_lnd; s_lnd = s_pre; s_pre = t_; } \
            if (__any((lsx > 65536.f) || (m != 0.f))) { const float dl = (lsx > 65536.f) ? __log2f(lsx) : 0.f; const float al = __builtin_amdgcn_exp2f(-dl); m += dl; l *= al; \
                _Pragma("unroll") for (int i = 0; i < 16; ++i) { o0[i] *= al; o1[i] *= al; N0[i] -= m; N1[i] -= m; } } \
            } while (0)
        for (int kt = kt0; kt < kt1; kt += 2) { MLA_STEP(cA0, cA1, cB0, cB1, kt); MLA_STEP(cB0, cB1, cA0, cA1, kt + 1); }
        __syncthreads();
#undef MLA_STEP
#undef MLA_DMA
#undef MLA_QK
#undef MLA_MFMA
        const float il = 1.f / xhalf_sum(l);
        bf16_t* yp = Y + (size_t)qrow * 1024 + 512 + h * 64 + 4 * hi;
#pragma unroll
        for (int g = 0; g < 4; ++g) { u32x2 w; w.x = pk2(o0[4 * g] * il, o0[4 * g + 1] * il); w.y = pk2(o0[4 * g + 2] * il, o0[4 * g + 3] * il); *(u32x2*)(yp + 8 * g) = w;
            u32x2 x; x.x = pk2(o1[4 * g] * il, o1[4 * g + 1] * il); x.y = pk2(o1[4 * g + 2] * il, o1[4 * g + 3] * il); *(u32x2*)(yp + 32 + 8 * g) = x; }
    }
}

__device__ __forceinline__ void mla_attn_w64(const P& p, LAS unsigned char* lds, int bid, int G, int tid, int wave, int lane) {
    const bf16_t* QA = (const bf16_t*)(p.ws + WS_QA); const bf16_t* KA = (const bf16_t*)(p.ws + WS_KA); const bf16_t* VT = (const bf16_t*)(p.ws + WS_VT);
    bf16_t* Y = (bf16_t*)p.out;
    const int vcu = (G % 8 == 0) ? (bid % 8) * (G / 8) + bid / 8 : bid;
    const int r32 = lane & 31, hi = lane >> 5;
#define W64_MFMA(a, bq, c) __builtin_amdgcn_mfma_f32_32x32x16_bf16((a), (bq), (c), 0, 0, 0)
    for (int u = vcu; u < 512 + 32; u += G) {
        int b, h, qrow0, kt0, rmask; const int kt1 = 132;
        if (u < 512) { const int bh = u >> 4; b = bh >> 3; h = bh & 7; qrow0 = b * SEQ + (u & 15) * 512; kt0 = 0; rmask = 511; }
        else { const int bh = u - 512; b = bh >> 3; h = bh & 7; qrow0 = NLAT + b * CTXL; kt0 = 128; rmask = 255; }
        const int qrowA = qrow0 + ((wave * 64 + r32) & rmask), qrowB = qrow0 + ((wave * 64 + 32 + r32) & rmask);
        bf16x8 qfA[6], qfB[6];
#pragma unroll
        for (int tl = 0; tl < 2; ++tl) { const int qrow = tl ? qrowB : qrowA; float qv[6][8];
#pragma unroll
          for (int ks = 0; ks < 6; ++ks) { const u32x4 w = *(const u32x4*)(QA + (size_t)qrow * 768 + h * 96 + 16 * ks + 8 * hi);
              qv[ks][0] = bflo(w.x); qv[ks][1] = bfhi(w.x); qv[ks][2] = bflo(w.y); qv[ks][3] = bfhi(w.y); qv[ks][4] = bflo(w.z); qv[ks][5] = bfhi(w.z); qv[ks][6] = bflo(w.w); qv[ks][7] = bfhi(w.w); }
          if (u < 512) { const int t = qrow & 8191;
#pragma unroll
              for (int j = 0; j < 8; ++j) { const float ang = rope_angle(t, 8 * hi + j); const float cs = cosf(ang), sn = sinf(ang);
                  const float xa = qv[4][j], xb = qv[5][j]; qv[4][j] = xa * cs - xb * sn; qv[5][j] = xa * sn + xb * cs; } }
          const float sc = 0.10206207261596577f * 1.4426950408889634f;
#pragma unroll
          for (int ks = 0; ks < 6; ++ks) { u32x4 w; w.x = pk2(qv[ks][0] * sc, qv[ks][1] * sc); w.y = pk2(qv[ks][2] * sc, qv[ks][3] * sc); w.z = pk2(qv[ks][4] * sc, qv[ks][5] * sc); w.w = pk2(qv[ks][6] * sc, qv[ks][7] * sc);
              if (tl) qfB[ks] = __builtin_bit_cast(bf16x8, w); else qfA[ks] = __builtin_bit_cast(bf16x8, w); } }
        const bf16_t* VTh = VT + (size_t)(b * 8 + h) * 64 * 8448;
        const int pc1 = wave + 8, pc2 = min(wave + 16, 21);
        size_t dsrc0, dsrc1, dsrc2; bool v1;
        { const int s0_ = 64 * wave + lane; dsrc0 = (size_t)(s0_ / 13) * 768 + h * 96 + min(s0_ % 13, 11) * 8;
          v1 = pc1 >= 13;
          if (!v1) { const int s1_ = 64 * pc1 + lane; dsrc1 = (size_t)(s1_ / 13) * 768 + h * 96 + min(s1_ % 13, 11) * 8; }
          else { const int s1_ = 64 * (pc1 - 13) + lane; dsrc1 = (size_t)(s1_ / 9) * 8448 + min(s1_ % 9, 7) * 8; }
          const int s2_ = 64 * (pc2 - 13) + lane; dsrc2 = (size_t)(s2_ / 9) * 8448 + min(s2_ % 9, 7) * 8; }
#define W64_DMA(ST, KTL) do { const int ktl_ = (KTL); const bf16_t* kb_ = KA + (size_t)mla_tile_row0(b, ktl_) * 768; const bf16_t* vb_ = VTh + 64 * ktl_; LAS unsigned char* sb_ = lds + (ST) * MLA_BUF; \
            __builtin_amdgcn_global_load_lds((const unsigned*)(kb_ + dsrc0), (LAS unsigned*)(sb_ + wave * 1024), 16, 0, 0); \
            __builtin_amdgcn_global_load_lds((const unsigned*)((v1 ? vb_ : kb_) + dsrc1), (LAS unsigned*)(sb_ + pc1 * 1024), 16, 0, 0); \
            __builtin_amdgcn_global_load_lds((const unsigned*)(vb_ + dsrc2), (LAS unsigned*)(sb_ + pc2 * 1024), 16, 0, 0); } while (0)
        W64_DMA(0, kt0); W64_DMA(1, min(kt0 + 1, kt1 - 1));
        asm volatile("s_waitcnt vmcnt(3)\n\ts_barrier" ::: "memory");
        f32x16 oA0, oA1, oB0, oB1; const f32x16 z16 = {0.f, 0.f, 0.f, 0.f, 0.f, 0.f, 0.f, 0.f, 0.f, 0.f, 0.f, 0.f, 0.f, 0.f, 0.f, 0.f};
#pragma unroll
        for (int i = 0; i < 16; ++i) { oA0[i] = 0.f; oA1[i] = 0.f; oB0[i] = 0.f; oB1[i] = 0.f; }
        float mA = 0.f, mB = 0.f, lA = 0.f, lB = 0.f;
        int s_cur = 0, s_nxt = 1, s_pre = 2;
        for (int kt = kt0; kt < kt1; ++kt) {
            W64_DMA(s_pre, min(kt + 2, kt1 - 1));
            const LAS unsigned char* Vb_ = lds + s_cur * MLA_BUF + MLA_KB;
#pragma unroll
            for (int kh = 0; kh < 2; ++kh) {
                const LAS unsigned char* Kb_ = lds + s_cur * MLA_BUF + (32 * kh + r32) * MLA_KP + hi * 16;
                f32x16 SA, SB;
#pragma unroll
                for (int ks = 0; ks < 6; ++ks) { const bf16x8 kf_ = *(const LAS bf16x8*)(Kb_ + ks * 32);
                    if (ks == 0) { SA = W64_MFMA(kf_, qfA[0], z16); SB = W64_MFMA(kf_, qfB[0], z16); } else { SA = W64_MFMA(kf_, qfA[ks], SA); SB = W64_MFMA(kf_, qfB[ks], SB); } }
                if (__any((mA != 0.f) || (mB != 0.f))) {
#pragma unroll
                    for (int i = 0; i < 16; ++i) { SA[i] -= mA; SB[i] -= mB; } }
                float lsA = 0.f, lsB = 0.f;
#pragma unroll
                for (int i = 0; i < 16; ++i) { SA[i] = __builtin_amdgcn_exp2f(SA[i]); SB[i] = __builtin_amdgcn_exp2f(SB[i]); lsA += SA[i]; lsB += SB[i]; }
                lA += lsA; lB += lsB;
                const float lxA = xhalf_sum(lsA), lxB = xhalf_sum(lsB);
                if (__any((lxA > 65536.f) || (lxB > 65536.f))) {
                    const float dA = (lxA > 65536.f) ? __log2f(lxA) : 0.f, dB = (lxB > 65536.f) ? __log2f(lxB) : 0.f; const float aA = __builtin_amdgcn_exp2f(-dA), aB = __builtin_amdgcn_exp2f(-dB);
                    mA += dA; mB += dB; lA *= aA; lB *= aB;
#pragma unroll
                    for (int i = 0; i < 16; ++i) { oA0[i] *= aA; oA1[i] *= aA; SA[i] *= aA; oB0[i] *= aB; oB1[i] *= aB; SB[i] *= aB; } }
#pragma unroll
                for (int s2 = 0; s2 < 2; ++s2) { const int kb = (32 * kh + 16 * s2 + 8 * hi) * 2;
                    u32x4 wa, wb;
                    wa.x = cvtpk(SA[8 * s2], SA[8 * s2 + 1]); wa.y = cvtpk(SA[8 * s2 + 2], SA[8 * s2 + 3]); wa.z = cvtpk(SA[8 * s2 + 4], SA[8 * s2 + 5]); wa.w = cvtpk(SA[8 * s2 + 6], SA[8 * s2 + 7]);
                    wb.x = cvtpk(SB[8 * s2], SB[8 * s2 + 1]); wb.y = cvtpk(SB[8 * s2 + 2], SB[8 * s2 + 3]); wb.z = cvtpk(SB[8 * s2 + 4], SB[8 * s2 + 5]); wb.w = cvtpk(SB[8 * s2 + 6], SB[8 * s2 + 7]);
                    const bf16x8 pa_ = __builtin_bit_cast(bf16x8, wa), pb_ = __builtin_bit_cast(bf16x8, wb);
                    const bf16x8 va_ = *(const LAS bf16x8*)(Vb_ + r32 * MLA_VP + kb), vb_ = *(const LAS bf16x8*)(Vb_ + (32 + r32) * MLA_VP + kb);
                    oA0 = W64_MFMA(va_, pa_, oA0); oA1 = W64_MFMA(vb_, pa_, oA1); oB0 = W64_MFMA(va_, pb_, oB0); oB1 = W64_MFMA(vb_, pb_, oB1); }
            }
            asm volatile("s_waitcnt vmcnt(3) lgkmcnt(0)\n\ts_barrier" ::: "memory");
            { const int t_ = s_cur; s_cur = s_nxt; s_nxt = s_pre; s_pre = t_; }
        }
        asm volatile("s_waitcnt vmcnt(0)" ::: "memory");
        __syncthreads();
        const float ilA = 1.f / xhalf_sum(lA), ilB = 1.f / xhalf_sum(lB);
        bf16_t* ypA = Y + (size_t)qrowA * 1024 + 512 + h * 64 + 4 * hi; bf16_t* ypB = Y + (size_t)qrowB * 1024 + 512 + h * 64 + 4 * hi;
#pragma unroll
        for (int g = 0; g < 4; ++g) { u32x2 w; w.x = pk2(oA0[4 * g] * ilA, oA0[4 * g + 1] * ilA); w.y = pk2(oA0[4 * g + 2] * ilA, oA0[4 * g + 3] * ilA); *(u32x2*)(ypA + 8 * g) = w;
            u32x2 x; x.x = pk2(oA1[4 * g] * ilA, oA1[4 * g + 1] * ilA); x.y = pk2(oA1[4 * g + 2] * ilA, oA1[4 * g + 3] * ilA); *(u32x2*)(ypA + 32 + 8 * g) = x;
            u32x2 y; y.x = pk2(oB0[4 * g] * ilB, oB0[4 * g + 1] * ilB); y.y = pk2(oB0[4 * g + 2] * ilB, oB0[4 * g + 3] * ilB); *(u32x2*)(ypB + 8 * g) = y;
            u32x2 z; z.x = pk2(oB1[4 * g] * ilB, oB1[4 * g + 1] * ilB); z.y = pk2(oB1[4 * g + 2] * ilB, oB1[4 * g + 3] * ilB); *(u32x2*)(ypB + 32 + 8 * g) = z; }
    }
#undef W64_MFMA
#undef W64_DMA
}

__device__ __forceinline__ float logsigmoid(float x) { return fminf(x, 0.f) - log1pf(expf(-fabsf(x))); }
__device__ __forceinline__ int chunk_row0(int b, int tc) { return tc < 4 ? NLAT + b * CTXL + 64 * tc : b * SEQ + 64 * (tc - 4); }
__device__ __forceinline__ int chunk_cdir(int d, int tc) { return d ? (tc < 4 ? 3 - tc : 135 - tc) : tc; }
__device__ __forceinline__ float wave_prefix_sum(float v, int lane) {
#pragma unroll
    for (int o = 1; o < 64; o <<= 1) { const float t = __shfl_up(v, o); if (lane >= o) v += t; }
    return v;
}
__device__ __forceinline__ float wave_prefix_max(float v, int lane) {
#pragma unroll
    for (int o = 1; o < 64; o <<= 1) { const float t = __shfl_up(v, o); if (lane >= o) v = fmaxf(v, t); }
    return v;
}
__device__ __forceinline__ float wave_max(float v) {
#pragma unroll
    for (int o = 1; o < 64; o <<= 1) v = fmaxf(v, __shfl_xor(v, o));
    return v;
}
__device__ __forceinline__ void stage_T(const bf16_t* src, LAS unsigned char* img, int pitchB, int tid) {
#pragma unroll
    for (int rep = 0; rep < 2; ++rep) { const int ci = tid + 512 * rep, t = ci & 63, dc = ci >> 6;
        const u32x4 w = *(const u32x4*)(src + (size_t)t * ABPAD + dc * 8);
        LAS unsigned char* d = img + (dc * 8) * pitchB + 2 * t;
        *(LAS bf16_t*)(d) = (bf16_t)(w.x & 0xffff); *(LAS bf16_t*)(d + pitchB) = (bf16_t)(w.x >> 16);
        *(LAS bf16_t*)(d + 2 * pitchB) = (bf16_t)(w.y & 0xffff); *(LAS bf16_t*)(d + 3 * pitchB) = (bf16_t)(w.y >> 16);
        *(LAS bf16_t*)(d + 4 * pitchB) = (bf16_t)(w.z & 0xffff); *(LAS bf16_t*)(d + 5 * pitchB) = (bf16_t)(w.z >> 16);
        *(LAS bf16_t*)(d + 6 * pitchB) = (bf16_t)(w.w & 0xffff); *(LAS bf16_t*)(d + 7 * pitchB) = (bf16_t)(w.w >> 16); }
}
__device__ __forceinline__ void stage_N(const bf16_t* src, LAS unsigned char* img, int tid) {
#pragma unroll
    for (int rep = 0; rep < 2; ++rep) { const int ci = tid + 512 * rep, t = ci >> 4, dc = ci & 15;
        *(LAS u32x4*)(img + t * 272 + dc * 16) = *(const u32x4*)(src + (size_t)t * ABPAD + dc * 8); }
}
__device__ __forceinline__ void mlstm_A(const P& p, LAS unsigned char* lds, int bid, int G, int tid, int wave, int lane) {
    const bf16_t* PROJ = (const bf16_t*)(p.ws + WS_PROJ); bf16_t* ST = (bf16_t*)(p.ws + WS_ST); float* SC = (float*)(p.ws + WS_SC);
    LAS unsigned char* KT = lds; LAS unsigned char* VT = lds + 18432; LAS float* W = (LAS float*)(lds + 36864);
    const int r32 = lane & 31, hi = lane >> 5;
    for (int item = bid; item < 2112; item += G) {
        const int bh = item / 132, tc = item % 132, b = bh >> 2, h = bh & 3; const int row0 = chunk_row0(b, tc);
        __syncthreads();
        stage_T(PROJ + (size_t)row0 * ABPAD + C_MK + h * 128, KT, 144, tid);
        stage_T(PROJ + (size_t)row0 * ABPAD + C_MV + h * 128, VT, 144, tid);
        if (wave < 2) { const int d = wave, t = d ? 63 - lane : lane; const bf16_t* g = PROJ + (size_t)(row0 + t) * ABPAD + C_MG;
            const float li = bf2f(g[(2 * d) * 4 + h]) + p.in[I_GATEB][(2 * d) * 4 + h]; const float lf = logsigmoid(bf2f(g[(2 * d + 1) * 4 + h]) + p.in[I_GATEB][(2 * d + 1) * 4 + h]);
            const float bs = wave_prefix_sum(lf, lane); const float blast = __shfl(bs, 63); const float gg = blast - bs + li; const float a = wave_max(gg);
            W[d * 64 + t] = __expf(gg - a);
            if (lane == 0) { float* sc = SC + ((size_t)(d * 16 + bh) * 132 + chunk_cdir(d, tc)) * 2; sc[0] = blast; sc[1] = a; } }
        __syncthreads();
        { const int d = wave >> 2, kt = wave & 3;
          bf16_t* slot = ST + ((size_t)(d * 16 + bh) * 132 + chunk_cdir(d, tc)) * ST_SLOT;
          bf16x8 af[4];
#pragma unroll
          for (int ks = 0; ks < 4; ++ks) { const u32x4 w = *(const LAS u32x4*)(KT + (32 * kt + r32) * 144 + (16 * ks + 8 * hi) * 2); const LAS float* ww = W + d * 64 + 16 * ks + 8 * hi;
              u32x4 o; o.x = pk2(bflo(w.x) * ww[0], bfhi(w.x) * ww[1]); o.y = pk2(bflo(w.y) * ww[2], bfhi(w.y) * ww[3]); o.z = pk2(bflo(w.z) * ww[4], bfhi(w.z) * ww[5]); o.w = pk2(bflo(w.w) * ww[6], bfhi(w.w) * ww[7]);
              af[ks] = __builtin_bit_cast(bf16x8, o); }
#pragma unroll
          for (int nt = 0; nt < 4; ++nt) { f32x16 acc;
#pragma unroll
              for (int i = 0; i < 16; ++i) acc[i] = 0.f;
#pragma unroll
              for (int ks = 0; ks < 4; ++ks) { const bf16x8 bfr = *(const LAS bf16x8*)(VT + (32 * nt + r32) * 144 + (16 * ks + 8 * hi) * 2); acc = __builtin_amdgcn_mfma_f32_32x32x16_bf16(af[ks], bfr, acc, 0, 0, 0); }
              bf16_t* op = slot + (size_t)(32 * nt + r32) * 128 + 32 * kt + 4 * hi;
#pragma unroll
              for (int g = 0; g < 4; ++g) { u32x2 w; w.x = pk2(acc[4 * g], acc[4 * g + 1]); w.y = pk2(acc[4 * g + 2], acc[4 * g + 3]); *(u32x2*)(op + 8 * g) = w; } }
        }
        if (tid < 256) { const int d = tid >> 7, dk = tid & 127; float s = 0.f;
#pragma unroll
            for (int c8 = 0; c8 < 8; ++c8) { const u32x4 w = *(const LAS u32x4*)(KT + dk * 144 + c8 * 16); const LAS float* ww = W + d * 64 + 8 * c8;
                s += (bflo(w.x) * ww[0] + bfhi(w.x) * ww[1]) + (bflo(w.y) * ww[2] + bfhi(w.y) * ww[3]) + (bflo(w.z) * ww[4] + bfhi(w.z) * ww[5]) + (bflo(w.w) * ww[6] + bfhi(w.w) * ww[7]); }
            ST[((size_t)(d * 16 + bh) * 132 + chunk_cdir(d, tc)) * ST_SLOT + 128 * 128 + dk] = (bf16_t)f2bf(s); }
    }
}
__device__ __forceinline__ void mlstm_B(const P& p, int bid, int tid) {
    const int gid = bid * 512 + tid;
    if (gid >= 32 * 2064) return;
    const int seq = gid / 2064, it = gid % 2064;
    bf16_t* slot = (bf16_t*)(p.ws + WS_ST) + (size_t)seq * 132 * ST_SLOT + it * 8;
    const float* sc = (const float*)(p.ws + WS_SC) + (size_t)seq * 132 * 2; float* ms = (float*)(p.ws + WS_MS) + seq * 132;
    float C[8];
#pragma unroll
    for (int e = 0; e < 8; ++e) C[e] = 0.f;
    float m = 0.f;
    for (int c0 = 0; c0 < 132; c0 += 12) {
        u32x4 w[12]; float bl[12], aa[12];
#pragma unroll
        for (int k = 0; k < 12; ++k) { w[k] = *(const u32x4*)(slot + (size_t)(c0 + k) * ST_SLOT); bl[k] = sc[(c0 + k) * 2]; aa[k] = sc[(c0 + k) * 2 + 1]; }
#pragma unroll
        for (int k = 0; k < 12; ++k) {
            u32x4 o; o.x = pk2(C[0], C[1]); o.y = pk2(C[2], C[3]); o.z = pk2(C[4], C[5]); o.w = pk2(C[6], C[7]);
            *(u32x4*)(slot + (size_t)(c0 + k) * ST_SLOT) = o;
            if (it == 0) ms[c0 + k] = m;
            const float mn = fmaxf(bl[k] + m, aa[k]); const float dec = __expf(bl[k] + m - mn), win = __expf(aa[k] - mn); m = mn;
            C[0] = dec * C[0] + win * bflo(w[k].x); C[1] = dec * C[1] + win * bfhi(w[k].x); C[2] = dec * C[2] + win * bflo(w[k].y); C[3] = dec * C[3] + win * bfhi(w[k].y);
            C[4] = dec * C[4] + win * bflo(w[k].z); C[5] = dec * C[5] + win * bfhi(w[k].z); C[6] = dec * C[6] + win * bflo(w[k].w); C[7] = dec * C[7] + win * bfhi(w[k].w);
        }
    }
}
__device__ __forceinline__ void mlstm_C(const P& p, LAS unsigned char* lds, int bid, int G, int tid, int wave, int lane) {
    const bf16_t* PROJ = (const bf16_t*)(p.ws + WS_PROJ); const bf16_t* ST = (const bf16_t*)(p.ws + WS_ST); const float* MS = (const float*)(p.ws + WS_MS);
    bf16_t* Y = (bf16_t*)p.out;
    LAS unsigned char* Qi = lds; LAS unsigned char* Ki = lds + 17408; LAS unsigned char* VTi = lds + 34816;
    LAS float* Bv = (LAS float*)(lds + 52224); LAS float* Uv = Bv + 128; LAS float* MTv = Uv + 128; LAS float* WIv = MTv + 128; LAS float* SS = WIv + 128;
    LAS unsigned char* NV = lds + 52224 + 4096;
    const int r32 = lane & 31, hi = lane >> 5, tt = wave & 1, dq = wave >> 1, t = 32 * tt + r32;
    const float qs = 0.08838834764831845f;
    for (int item = bid; item < 2112; item += G) {
        const int bh = item / 132, tc = item % 132, b = bh >> 2, h = bh & 3; const int row0 = chunk_row0(b, tc);
        const bf16_t* slot0 = ST + ((size_t)bh * 132 + chunk_cdir(0, tc)) * ST_SLOT; const bf16_t* slot1 = ST + ((size_t)(16 + bh) * 132 + chunk_cdir(1, tc)) * ST_SLOT;
        bf16x8 cf[8]; u32x2 owv[4];
#pragma unroll
        for (int ks = 0; ks < 8; ++ks) cf[ks] = *(const bf16x8*)(slot0 + (size_t)(32 * dq + r32) * 128 + 16 * ks + 8 * hi);
#pragma unroll
        for (int g = 0; g < 4; ++g) owv[g] = *(const u32x2*)(PROJ + (size_t)(row0 + t) * ABPAD + C_MO + h * 128 + 32 * dq + 8 * g + 4 * hi);
        __syncthreads();
        stage_N(PROJ + (size_t)row0 * ABPAD + C_MQ + h * 128, Qi, tid);
        stage_N(PROJ + (size_t)row0 * ABPAD + C_MK + h * 128, Ki, tid);
        stage_T(PROJ + (size_t)row0 * ABPAD + C_MV + h * 128, VTi, 136, tid);
        if (tid < 32) { const int d = tid >> 4, ch = tid & 15; *(LAS u32x4*)(NV + d * 256 + ch * 16) = *(const u32x4*)((d ? slot1 : slot0) + 128 * 128 + ch * 8); }
        if (wave < 2) { const int d = wave, tk = d ? 63 - lane : lane; const bf16_t* g = PROJ + (size_t)(row0 + tk) * ABPAD + C_MG;
            const float li = bf2f(g[(2 * d) * 4 + h]) + p.in[I_GATEB][(2 * d) * 4 + h]; const float lf = logsigmoid(bf2f(g[(2 * d + 1) * 4 + h]) + p.in[I_GATEB][(2 * d + 1) * 4 + h]);
            const float bs = wave_prefix_sum(lf, lane); const float uu = li - bs; const float pm = wave_prefix_max(uu, lane);
            const float mc = MS[(size_t)(d * 16 + bh) * 132 + chunk_cdir(d, tc)]; const float mt = bs + fmaxf(mc, pm);
            Bv[d * 64 + tk] = bs; Uv[d * 64 + tk] = uu; MTv[d * 64 + tk] = mt; WIv[d * 64 + tk] = __expf(bs + mc - mt); }
        __syncthreads();
#define QF(ks) (*(const LAS bf16x8*)(Qi + t * 272 + (16 * (ks) + 8 * hi) * 2))
        f32x16 S0, S1;
#pragma unroll
        for (int i = 0; i < 16; ++i) { S0[i] = 0.f; S1[i] = 0.f; }
#pragma unroll
        for (int ks = 0; ks < 8; ++ks) { const bf16x8 k0 = *(const LAS bf16x8*)(Ki + r32 * 272 + (16 * ks + 8 * hi) * 2), k1 = *(const LAS bf16x8*)(Ki + (32 + r32) * 272 + (16 * ks + 8 * hi) * 2);
            const bf16x8 qq = QF(ks); S0 = __builtin_amdgcn_mfma_f32_32x32x16_bf16(k0, qq, S0, 0, 0, 0); S1 = __builtin_amdgcn_mfma_f32_32x32x16_bf16(k1, qq, S1, 0, 0, 0); }
        __builtin_amdgcn_sched_barrier(0);
        f32x16 hs;
#pragma unroll
        for (int i = 0; i < 16; ++i) hs[i] = 0.f;
#pragma unroll 1
        for (int d = 0; d < 2; ++d) {
            const float bt = Bv[d * 64 + t], mtt = MTv[d * 64 + t], wi = WIv[d * 64 + t] * qs; const int tsel = d ? 63 - t : t;
            f32x16 acc;
#pragma unroll
            for (int i = 0; i < 16; ++i) acc[i] = 0.f;
#pragma unroll
            for (int ks = 0; ks < 8; ++ks) acc = __builtin_amdgcn_mfma_f32_32x32x16_bf16(cf[ks], QF(ks), acc, 0, 0, 0);
            __builtin_amdgcn_sched_barrier(0);
#pragma unroll
            for (int ks = 0; ks < 8; ++ks) cf[ks] = *(const bf16x8*)(slot1 + (size_t)(32 * dq + r32) * 128 + 16 * ks + 8 * hi);
            float dn = 0.f;
#pragma unroll
            for (int c8 = 0; c8 < 8; ++c8) { const u32x4 qw = *(const LAS u32x4*)(Qi + t * 272 + (64 * hi + 8 * c8) * 2); const u32x4 nw = *(const LAS u32x4*)(NV + d * 256 + (64 * hi + 8 * c8) * 2);
                dn += (bflo(qw.x) * bflo(nw.x) + bfhi(qw.x) * bfhi(nw.x)) + (bflo(qw.y) * bflo(nw.y) + bfhi(qw.y) * bfhi(nw.y)) + (bflo(qw.z) * bflo(nw.z) + bfhi(qw.z) * bfhi(nw.z)) + (bflo(qw.w) * bflo(nw.w) + bfhi(qw.w) * bfhi(nw.w)); }
            dn = xhalf_sum(dn);
            __builtin_amdgcn_sched_barrier(0);
#pragma unroll
            for (int i = 0; i < 16; ++i) acc[i] *= wi;
            float rs = 0.f;
#pragma unroll
            for (int st = 0; st < 2; ++st) { float pv[16];
#pragma unroll
                for (int i = 0; i < 16; ++i) { const int sp = 32 * st + (i & 3) + 8 * (i >> 2) + 4 * hi;
                    const bool vld = (d ? 63 - sp : sp) <= tsel;
                    const float e = __expf(bt + Uv[d * 64 + sp] - mtt);
                    pv[i] = vld ? (st ? S1[i] : S0[i]) * qs * e : 0.f; rs += pv[i]; }
#pragma unroll
                for (int s = 0; s < 2; ++s) {
                    u32x4 w; w.x = cvtpk(pv[8 * s], pv[8 * s + 1]); w.y = cvtpk(pv[8 * s + 2], pv[8 * s + 3]); w.z = cvtpk(pv[8 * s + 4], pv[8 * s + 5]); w.w = cvtpk(pv[8 * s + 6], pv[8 * s + 7]);
                    const int kb = (32 * st + 16 * s + 4 * hi) * 2;
                    const u32x2 a0 = *(const LAS u32x2*)(VTi + (32 * dq + r32) * 136 + kb), a1 = *(const LAS u32x2*)(VTi + (32 * dq + r32) * 136 + kb + 16);
                    acc = __builtin_amdgcn_mfma_f32_32x32x16_bf16(__builtin_bit_cast(bf16x8, (u32x4){a0.x, a0.y, a1.x, a1.y}), __builtin_bit_cast(bf16x8, w), acc, 0, 0, 0); } }
            __builtin_amdgcn_sched_barrier(0);
            const float den = wi * dn + xhalf_sum(rs);
            const float inv = 1.f / fmaxf(fabsf(den), __expf(-mtt));
#pragma unroll
            for (int i = 0; i < 16; ++i) hs[i] += acc[i] * inv;
        }
        float ssq = 0.f;
#pragma unroll
        for (int i = 0; i < 16; ++i) ssq += hs[i] * hs[i];
        ssq = xhalf_sum(ssq);
        if (hi == 0) SS[dq * 64 + t] = ssq;
        __syncthreads();
        const float rstd = rsqrtf(((SS[t] + SS[64 + t]) + (SS[128 + t] + SS[192 + t])) * (1.f / 128.f) + EPS);
        const int row = row0 + t;
#pragma unroll
        for (int g = 0; g < 4; ++g) { const int dv = 32 * dq + 8 * g + 4 * hi;
            const u32x2 ow = owv[g]; const f32x4 gg = *(const f32x4*)(p.in[I_MNG] + h * 128 + dv);
            const float y0 = hs[4 * g] * rstd * gg.x / (1.f + __expf(-bflo(ow.x))), y1 = hs[4 * g + 1] * rstd * gg.y / (1.f + __expf(-bfhi(ow.x)));
            const float y2 = hs[4 * g + 2] * rstd * gg.z / (1.f + __expf(-bflo(ow.y))), y3 = hs[4 * g + 3] * rstd * gg.w / (1.f + __expf(-bfhi(ow.y)));
            u32x2 w; w.x = pk2(y0, y1); w.y = pk2(y2, y3); *(u32x2*)(Y + (size_t)row * 1024 + h * 128 + dv) = w; }
    }
}

struct EpiQKV1 {
    static constexpr bool PERM = true, AFTER_DRAIN = false;
    bf16_t* O; bf16_t* VT1;
    __device__ __forceinline__ void operator()(const pg8::f32x4 (&acc)[2][2][4][2], const pg8::Unit& u, int wr, int wc, int fr, int fq) const {
        const int row0 = u.pm * 256 + wr * 64 + fr, col0 = u.pn * 256 + wc * 32 + 8 * fq;
#pragma unroll
        for (int ai = 0; ai < 2; ++ai)
#pragma unroll
            for (int m = 0; m < 4; ++m) { const int row = row0 + ai * 128 + m * 16;
                int b, key; if (row < NLAT) { b = row >> 13; key = row & 8191; } else { b = (row - NLAT) >> 8; key = SEQ + ((row - NLAT) & 255); }
#pragma unroll
                for (int bj = 0; bj < 2; ++bj) { const pg8::f32x4 v0 = acc[ai][bj][m][0], v1 = acc[ai][bj][m][1]; const int c = col0 + bj * 128;
                    if (u.pn < 8) { u32x4 w; w.x = pk2(v0[0], v0[1]); w.y = pk2(v0[2], v0[3]); w.z = pk2(v1[0], v1[1]); w.w = pk2(v1[2], v1[3]); *(u32x4*)(O + (size_t)row * 3072 + c) = w; }
                    else { const int cv = c - 2048; bf16_t* vp = VT1 + ((size_t)(b * 16 + (cv >> 6)) * 64 + (cv & 63)) * 8448 + key;
#pragma unroll
                        for (int e = 0; e < 4; ++e) { vp[(size_t)e * 8448] = (bf16_t)f2bf(v0[e]); vp[(size_t)(e + 4) * 8448] = (bf16_t)f2bf(v1[e]); } } } }
    }
};
constexpr int NA_KC = 0, NA_VTC = 36864, NA_BT = 70656, NA_WIN = 72960, NA_WK = 9216, NA_WBUF = 9216 + 8704;
template <int SKIP> __device__ __forceinline__ void na_phase(const P& p, LAS unsigned char* lds, int bid, int G, int tid, int wave, int lane) {
    const bf16_t* QKV = (const bf16_t*)(p.ws + WS_BIG); const bf16_t* VT1 = (const bf16_t*)(p.ws + WS_VT1); bf16_t* Y = SKIP ? (bf16_t*)(p.ws + WS_XN) : (bf16_t*)p.out;
    LAS unsigned char* Kc = lds + NA_KC; LAS unsigned char* VTc = lds + NA_VTC; LAS float* BT0 = (LAS float*)(lds + NA_BT); LAS float* BT = BT0 + 32;
    const int r16 = lane & 15, g4 = lane >> 4;
    const float L2E = 1.4426950408889634f, sc = 0.125f * L2E;
    const int st_t = tid >> 3, st_c = tid & 7;
    for (int item = bid; item < 1024; item += G) {
        const int bh = item >> 4, R = item & 15, b = bh >> 4, h = bh & 15;
        const bf16_t* VTh = VT1 + (size_t)bh * 64 * 8448;
        const int krlo = min(max(8 * R - 4, 0), 120), krhi = min(max(8 * R + 3, 0), 120) + 7;
        __syncthreads();
#pragma unroll
        for (int rep = 0; rep < 4; ++rep) { const int ci = tid + 512 * rep;
            { const int row = ci >> 3, ch = ci & 7; *(LAS u32x4*)(Kc + row * 144 + ch * 16) = *(const u32x4*)(QKV + (size_t)(NLAT + b * CTXL + row) * 3072 + 1024 + h * 64 + ch * 8); }
            { const int d = ci >> 5, ch = ci & 31; *(LAS u32x4*)(VTc + d * 528 + ch * 16) = *(const u32x4*)(VTh + (size_t)d * 8448 + SEQ + ch * 8); } }
        if (tid < 465) BT[tid] = p.in[I_RELB][h * 465 + tid] * L2E; else if (tid < 465 + 32) BT[tid] = 0.f;
        if (tid < 32) BT0[tid] = 0.f;
        { const u32x4 kw = *(const u32x4*)(QKV + (size_t)(b * SEQ + krlo * 64 + st_t) * 3072 + 1024 + h * 64 + st_c * 8); const u32x4 vw = *(const u32x4*)(VTh + (size_t)st_t * 8448 + krlo * 64 + st_c * 8);
          LAS unsigned char* wb = lds + NA_WIN; *(LAS u32x4*)(wb + st_t * 144 + st_c * 16) = kw;
          *(LAS u32x2*)(wb + NA_WK + st_t * 136 + st_c * 16) = (u32x2){vw.x, vw.y}; *(LAS u32x2*)(wb + NA_WK + st_t * 136 + st_c * 16 + 8) = (u32x2){vw.z, vw.w}; }
        __syncthreads();
        const int r = 8 * R + wave, rs = min(max(r - 4, 0), 120);
        const int qrow0 = b * SEQ + r * 64;
        bf16x8 qf[4][2]; unsigned vmask[4]; f32x4 o[4][4]; float ls[4];
#pragma unroll
        for (int g = 0; g < 4; ++g) { const int qcol = 16 * g + r16, cs = min(max(qcol - 8, 0), 48), cA = (g == 0) ? 0 : (g == 1) ? 8 : (g == 2) ? 24 : 32;
#pragma unroll
            for (int ks = 0; ks < 2; ++ks) { const u32x4 w = *(const u32x4*)(QKV + (size_t)(qrow0 + qcol) * 3072 + h * 64 + 32 * ks + 8 * g4);
                u32x4 o4; o4.x = pk2(bflo(w.x) * sc, bfhi(w.x) * sc); o4.y = pk2(bflo(w.y) * sc, bfhi(w.y) * sc); o4.z = pk2(bflo(w.z) * sc, bfhi(w.z) * sc); o4.w = pk2(bflo(w.w) * sc, bfhi(w.w) * sc);
                qf[g][ks] = __builtin_bit_cast(bf16x8, o4); }
            vmask[g] = (0xffffu << (cs - cA)) >> (4 * g4);
#pragma unroll
            for (int dt = 0; dt < 4; ++dt) o[g][dt] = (f32x4){0.f, 0.f, 0.f, 0.f};
            ls[g] = 0.f; }
        const f32x4 z4 = {0.f, 0.f, 0.f, 0.f};
        for (int kr = krlo; kr <= krhi; ++kr) {
            const int cur = (kr - krlo) & 1; const bool more = kr < krhi;
            u32x4 kw = {0, 0, 0, 0}, vw = {0, 0, 0, 0};
            if (more) { kw = *(const u32x4*)(QKV + (size_t)(b * SEQ + (kr + 1) * 64 + st_t) * 3072 + 1024 + h * 64 + st_c * 8); vw = *(const u32x4*)(VTh + (size_t)st_t * 8448 + (kr + 1) * 64 + st_c * 8); }
            if (!(SKIP & 1) && kr >= rs && kr <= rs + 7) {
                const LAS unsigned char* Kw = lds + NA_WIN + cur * NA_WBUF; const LAS unsigned char* Vw = Kw + NA_WK;
                const LAS float* btr = BT + (kr - r + 7) * 31 + 4 * g4 + 15 - r16;
#pragma unroll
                for (int g = 0; g < 4; ++g) { const int cA = (g == 0) ? 0 : (g == 1) ? 8 : (g == 2) ? 24 : 32;
                    f32x4 sw[2];
#pragma unroll
                    for (int blk = 0; blk < 2; ++blk) { const int cst = cA + 16 * blk;
                        const bf16x8 k0 = *(const LAS bf16x8*)(Kw + (cst + r16) * 144 + 8 * g4 * 2), k1 = *(const LAS bf16x8*)(Kw + (cst + r16) * 144 + (32 + 8 * g4) * 2);
                        f32x4 acc = __builtin_amdgcn_mfma_f32_16x16x32_bf16(k0, qf[g][0], z4, 0, 0, 0); acc = __builtin_amdgcn_mfma_f32_16x16x32_bf16(k1, qf[g][1], acc, 0, 0, 0);
#pragma unroll
                        for (int j = 0; j < 4; ++j) { const float sv = acc[j] + btr[cst - 16 * g + j]; const float v = __builtin_amdgcn_exp2f(((vmask[g] >> (16 * blk + j)) & 1u) ? sv : -1e30f); sw[blk][j] = v; ls[g] += v; } }
                    u32x4 w; w.x = cvtpk(sw[0][0], sw[0][1]); w.y = cvtpk(sw[0][2], sw[0][3]); w.z = cvtpk(sw[1][0], sw[1][1]); w.w = cvtpk(sw[1][2], sw[1][3]);
                    const bf16x8 pb = __builtin_bit_cast(bf16x8, w);
#pragma unroll
                    for (int dt = 0; dt < 4; ++dt) { const LAS unsigned char* vr = Vw + (16 * dt + r16) * 136 + (cA + 4 * g4) * 2; const u32x2 a0 = *(const LAS u32x2*)(vr), a1 = *(const LAS u32x2*)(vr + 32);
                        o[g][dt] = __builtin_amdgcn_mfma_f32_16x16x32_bf16(__builtin_bit_cast(bf16x8, (u32x4){a0.x, a0.y, a1.x, a1.y}), pb, o[g][dt], 0, 0, 0); }
                    if (g & 1) __builtin_amdgcn_sched_barrier(0); }
            }
            if (more) { LAS unsigned char* wb = lds + NA_WIN + (cur ^ 1) * NA_WBUF; *(LAS u32x4*)(wb + st_t * 144 + st_c * 16) = kw;
                *(LAS u32x2*)(wb + NA_WK + st_t * 136 + st_c * 16) = (u32x2){vw.x, vw.y}; *(LAS u32x2*)(wb + NA_WK + st_t * 136 + st_c * 16 + 8) = (u32x2){vw.z, vw.w}; }
            __syncthreads();
        }
#pragma unroll
        for (int g = 0; g < 4; ++g) {
#pragma unroll 1
            for (int cq = 0; cq < ((SKIP & 2) ? 0 : 4); ++cq) {
                f32x4 sx[4];
#pragma unroll
                for (int cb = 0; cb < 4; ++cb) { f32x4 acc = z4;
#pragma unroll
                    for (int ks = 0; ks < 2; ++ks) { const bf16x8 kf = *(const LAS bf16x8*)(Kc + (64 * cq + 16 * cb + r16) * 144 + (32 * ks + 8 * g4) * 2); acc = __builtin_amdgcn_mfma_f32_16x16x32_bf16(kf, qf[g][ks], acc, 0, 0, 0); }
                    sx[cb] = acc; }
                float l2 = 0.f;
#pragma unroll
                for (int i = 0; i < 4; ++i)
#pragma unroll
                    for (int j = 0; j < 4; ++j) { sx[i][j] = __builtin_amdgcn_exp2f(sx[i][j]); l2 += sx[i][j]; }
                ls[g] += l2;
#pragma unroll
                for (int cp = 0; cp < 2; ++cp) { u32x4 w; w.x = cvtpk(sx[2 * cp][0], sx[2 * cp][1]); w.y = cvtpk(sx[2 * cp][2], sx[2 * cp][3]); w.z = cvtpk(sx[2 * cp + 1][0], sx[2 * cp + 1][1]); w.w = cvtpk(sx[2 * cp + 1][2], sx[2 * cp + 1][3]);
                    const bf16x8 pb = __builtin_bit_cast(bf16x8, w);
#pragma unroll
                    for (int dt = 0; dt < 4; ++dt) { const LAS unsigned char* vr = VTc + (16 * dt + r16) * 528 + (64 * cq + 32 * cp + 4 * g4) * 2; const u32x2 a0 = *(const LAS u32x2*)(vr), a1 = *(const LAS u32x2*)(vr + 32);
                        o[g][dt] = __builtin_amdgcn_mfma_f32_16x16x32_bf16(__builtin_bit_cast(bf16x8, (u32x4){a0.x, a0.y, a1.x, a1.y}), pb, o[g][dt], 0, 0, 0); } }
            }
            float lt = ls[g] + __shfl_xor(ls[g], 16); lt += __shfl_xor(lt, 32);
            const float il = 1.f / lt;
            bf16_t* yp = Y + (size_t)(qrow0 + 16 * g + r16) * 1024 + h * 64 + 4 * g4;
#pragma unroll
            for (int dt = 0; dt < 4; ++dt) { u32x2 w; w.x = pk2(o[g][dt][0] * il, o[g][dt][1] * il); w.y = pk2(o[g][dt][2] * il, o[g][dt][3] * il); *(u32x2*)(yp + 16 * dt) = w; }
        }
    }
}

__device__ __forceinline__ void final_norm_phase(const P& p, int gw, int NGW, int lane) {
    const bf16_t* XR = (const bf16_t*)(p.ws + WS_XR);
    for (int row0 = gw; row0 < NLAT; row0 += 2 * NGW) {
        f32x4 v[2][4]; float s[2] = {0.f, 0.f};
#pragma unroll
        for (int r = 0; r < 2; ++r) { const int row = min(row0 + r * NGW, NLAT - 1); const u32x2* x16 = (const u32x2*)(XR + (size_t)row * DM) + lane;
#pragma unroll
            for (int j = 0; j < 4; ++j) { const u32x2 w = __builtin_nontemporal_load(x16 + 64 * j); v[r][j] = (f32x4){bflo(w.x), bfhi(w.x), bflo(w.y), bfhi(w.y)}; s[r] += (v[r][j].x * v[r][j].x + v[r][j].y * v[r][j].y) + (v[r][j].z * v[r][j].z + v[r][j].w * v[r][j].w); } }
        const float rs0 = rsqrtf(wave_sum(s[0]) * (1.f / DM) + EPS), rs1 = rsqrtf(wave_sum(s[1]) * (1.f / DM) + EPS);
        const f32x4* g4 = (const f32x4*)p.in[I_FNG] + lane;
#pragma unroll
        for (int r = 0; r < 2; ++r) { const int row = row0 + r * NGW;
            if (row < NLAT) { f32x4* xo = (f32x4*)(p.out + (size_t)row * DM) + lane; const float rstd = r ? rs1 : rs0;
#pragma unroll
                for (int j = 0; j < 4; ++j) __builtin_nontemporal_store(v[r][j] * rstd * g4[64 * j], xo + 64 * j); } }
    }
}

template <class Epi> __device__ __forceinline__ void run_gemm(LAS unsigned char* lds, const bf16_t* A, const bf16_t* Bt, int M, int N, int K, int G, int bid, const Epi& E, int ld = 0) {
    int Kv = K; asm volatile("" : "+s"(Kv));
    pg8::Gemm g{A, Bt, M, N, Kv, ld ? ld : Kv}; pg8::StaticOrder S; S.init(M, N, G, bid);
    pg8::gemm_phase<Epi, pg8::StaticOrder, true, true>(lds, g, S, E);
}
struct EpiPartial {
    static constexpr bool PERM = true, AFTER_DRAIN = false;
    float* P;
    __device__ __forceinline__ void operator()(const pg8::f32x4 (&acc)[2][2][4][2], const pg8::Unit& u, int wr, int wc, int fr, int fq) const {
        const int row0 = u.pm * 256 + wr * 64 + fr, col0 = u.pn * 256 + wc * 32 + 8 * fq;
#pragma unroll
        for (int ai = 0; ai < 2; ++ai)
#pragma unroll
            for (int m = 0; m < 4; ++m) { float* op = P + (size_t)(row0 + ai * 128 + m * 16) * DM + col0;
#pragma unroll
                for (int bj = 0; bj < 2; ++bj) { *(f32x4*)(op + bj * 128) = acc[ai][bj][m][0]; *(f32x4*)(op + bj * 128 + 4) = acc[ai][bj][m][1]; } }
    }
};
__device__ __forceinline__ void ctx_splitk_gemm(LAS unsigned char* lds, const bf16_t* Actx, const bf16_t* Bt, int Ktot, int NS, int G, int bid, float* P) {
    const int Ks = Ktot / NS;
#pragma unroll 1
    for (int s = 0; s < NS; ++s) run_gemm(lds, Actx + s * Ks, Bt + s * Ks, NCTX, 1024, Ks, G, (bid + G - 16 * s) % G, EpiPartial{P + (size_t)s * NCTX * DM}, Ktot);
}
#define XB_TMO      128
#define XB_XCNT(j)  (256  + 64 * (j))
#define XB_XSUB(j)  (1280 + 64 * (j))
#define XB_XGEN(j)  (2304 + 64 * (j))
#define XB_TOP      3328
#define XB_TOPGEN   3392
#define XCD_BAR_WORDS 3456
#define XB_SPIN_CAP (1u << 18)

__device__ __forceinline__ unsigned xb_ld(unsigned* p)              { return __hip_atomic_load(p, __ATOMIC_RELAXED, __HIP_MEMORY_SCOPE_AGENT); }
__device__ __forceinline__ unsigned xb_add(unsigned* p, unsigned v) { return __hip_atomic_fetch_add(p, v, __ATOMIC_RELAXED, __HIP_MEMORY_SCOPE_AGENT); }
__device__ __forceinline__ unsigned xb_xcc_id() { return (unsigned)__builtin_amdgcn_s_getreg((3 << 11) | 20) & 0xFu; }
#define XB_SPIN(cond, bar) do { unsigned _sp = 0; while (cond) { __builtin_amdgcn_s_sleep(1); \
    if ((++_sp & 255u) == 0u) { if (xb_ld(&(bar)[XB_TMO])) break; if (_sp > XB_SPIN_CAP) { atomicAdd(&(bar)[XB_TMO], 1u); break; } } } } while (0)

struct XcdBarrier {
    unsigned* bar; unsigned x;
    volatile LAS unsigned* st;
};

__device__ __forceinline__ XcdBarrier xcd_barrier_post(unsigned* bar, volatile LAS unsigned* st) {
    XcdBarrier b; b.bar = bar; b.x = xb_xcc_id(); b.st = st;
    if (threadIdx.x == 0) (void)xb_add(&bar[XB_XCNT(b.x)], 1u);
    return b;
}
__device__ __forceinline__ void xcd_barrier_complete(unsigned* bar, unsigned x, unsigned& nloc, unsigned& nx) {
    const unsigned G = gridDim.x * gridDim.y * gridDim.z;
    unsigned sum, cnt, mine, sp = 0u;
    for (;;) {
        sum = 0u; cnt = 0u; mine = 0u;
#pragma unroll
        for (unsigned j = 0; j < 16; ++j) { const unsigned c = xb_ld(&bar[XB_XCNT(j)]); sum += c; cnt += (c > 0u) ? 1u : 0u; mine = (j == x) ? c : mine; }
        if (sum == G) break;
        __builtin_amdgcn_s_sleep(1);
        if ((++sp & 255u) == 0u) { if (xb_ld(&bar[XB_TMO])) break; if (sp > XB_SPIN_CAP) { atomicAdd(&bar[XB_TMO], 1u); break; } }
    }
    nloc = mine > 0u ? mine : 1u; nx = cnt > 0u ? cnt : 1u;
}

__device__ __forceinline__ void xcd_barrier(const XcdBarrier& b) {
    asm volatile("s_waitcnt vmcnt(0)" ::: "memory");
    __syncthreads();
    if (threadIdx.x == 0) {
        unsigned* bar = b.bar;
        __builtin_amdgcn_s_waitcnt(0);
        unsigned nloc = b.st[0], nx = b.st[1];
        if (nloc == 0u) { xcd_barrier_complete(bar, b.x, nloc, nx); b.st[0] = nloc; b.st[1] = nx; }
        const unsigned old = xb_add(&bar[XB_XSUB(b.x)], 1u);
        const unsigned gen = old / nloc;
        if (old + 1u == (gen + 1u) * nloc) {
            __builtin_amdgcn_fence(__ATOMIC_RELEASE, "agent");
            asm volatile("s_waitcnt vmcnt(0)" ::: "memory");
            const unsigned og = xb_add(&bar[XB_TOP], 1u);
            const unsigned tg = og / nx;
            if (og + 1u == (tg + 1u) * nx) xb_add(&bar[XB_TOPGEN], 1u);
            else XB_SPIN(xb_ld(&bar[XB_TOPGEN]) == tg, bar);
            __builtin_amdgcn_fence(__ATOMIC_ACQUIRE, "agent");
            xb_add(&bar[XB_XGEN(b.x)], 1u);
            asm volatile("s_waitcnt vmcnt(0)" ::: "memory");
        } else {
            XB_SPIN(xb_ld(&bar[XB_XGEN(b.x)]) == gen, bar);
            __builtin_amdgcn_fence(__ATOMIC_ACQUIRE, "agent");
            asm volatile("s_waitcnt vmcnt(0)" ::: "memory");
        }
    }
    __syncthreads();
}

constexpr int N_PHASES = 64;
#ifndef REP_MASK
#define REP_MASK 0u
#endif
__global__ void __launch_bounds__(512) fwd_kernel(P p) {
    extern __shared__ __attribute__((aligned(16))) unsigned char lds_raw[];
    LAS unsigned char* lds = (LAS unsigned char*)lds_raw;
    cg::grid_group grid = cg::this_grid();
    const int tid = threadIdx.x, lane = tid & 63, wave = __builtin_amdgcn_readfirstlane(tid >> 6);
    const int G = gridDim.x, bid = blockIdx.x, gw = bid * 8 + wave, NGW = G * 8;
    unsigned char* ws = p.ws;
    float* MOD = (float*)(ws + WS_MOD); float* XCTX = (float*)(ws + WS_XCTX);
    bf16_t* XN = (bf16_t*)(ws + WS_XN); bf16_t* Y = (bf16_t*)p.out; bf16_t* U = (bf16_t*)(ws + WS_BIG);
    bf16_t* XR = (bf16_t*)(ws + WS_XR); float* P2 = (float*)((unsigned char*)p.out + 66 * MiB);
    const int lo = p.ph_lo, hi = p.ph_hi;
    volatile LAS unsigned* MISC = (volatile LAS unsigned*)(lds + LDS_BYTES - 64);
    if (tid < 16) MISC[tid] = 0u;
    unsigned* barw = (unsigned*)(ws + WS_BAR);
    if (bid == 0) for (int i = tid; i < XCD_BAR_WORDS; i += 512) barw[i] = 0u;
    __syncthreads();
    grid.sync();
    XcdBarrier xbar = xcd_barrier_post(barw, MISC + 8);
    int k = 0;
#define PHASE(...) do { if (lo <= k && k < hi) { __VA_ARGS__; if ((REP_MASK >> k) & 1u) { xcd_barrier(xbar); __VA_ARGS__; } } if (lo <= k && k + 1 < hi) xcd_barrier(xbar); ++k; } while (0)
    PHASE(p0_phase(p, lds, bid, G, tid, wave, lane));
    PHASE(modulate_phase(p.in[I_X], p.in[I_CTX], MT, p.in[I_N1G], MOD, 0, 1024, XN, gw, NGW, lane));
    PHASE(run_gemm(lds, XN, (const bf16_t*)(ws + WS_WIN), MT, ABPAD, 1024, G, bid, EpiBf16<0>{(bf16_t*)(ws + WS_PROJ), ABPAD}));
    PHASE(p3a_phase(p, gw, NGW, lane));
    PHASE(run_gemm(lds, (const bf16_t*)(ws + WS_CQN), (const bf16_t*)(ws + WS_WUQ), MT, 768, 256, G, bid, EpiBf16<0>{(bf16_t*)(ws + WS_QA), 768});
          run_gemm(lds, (const bf16_t*)(ws + WS_CKVN), (const bf16_t*)(ws + WS_WUKV), MT, 1024, 128, G, bid, EpiKV{(bf16_t*)(ws + WS_KA), (bf16_t*)(ws + WS_VT)}));
    PHASE(mla_attn_w64(p, lds, bid, G, tid, wave, lane));
#ifdef MLA_PROBE
    xcd_barrier(xbar); mla_attn_phase<MLA_PROBE>(p, lds, bid, G, tid, wave, lane); xcd_barrier(xbar);
#endif
    PHASE(mlstm_A(p, lds, bid, G, tid, wave, lane));
    PHASE(mlstm_B(p, bid, tid));
    PHASE(mlstm_C(p, lds, bid, G, tid, wave, lane));
    PHASE(run_gemm(lds, Y, (const bf16_t*)(ws + WS_WOUT), NLAT, 1024, 1024, G, bid, EpiRes16{p.in[I_X], XR, MOD + 2048});
          ctx_splitk_gemm(lds, Y + (size_t)NLAT * 1024, (const bf16_t*)(ws + WS_WOUT), 1024, 4, G, bid, (float*)(ws + WS_BIG)));
    PHASE(modulate_phase(nullptr, p.in[I_CTX], MT, p.in[I_N2G], MOD, 3072, 4096, XN, gw, NGW, lane, (const float*)(ws + WS_BIG), 4, MOD + 4 * 6144 + 2048, XCTX, XR));
    PHASE(run_gemm(lds, XN, (const bf16_t*)(ws + WS_W1), MT, FF, 1024, G, bid, EpiBf16<2>{U, FF}));
    PHASE(run_gemm(lds, U, (const bf16_t*)(ws + WS_W2), NLAT, 1024, FF, G, bid, EpiRes16{nullptr, XR, MOD + 5120});
          ctx_splitk_gemm(lds, U + (size_t)NLAT * FF, (const bf16_t*)(ws + WS_W2), FF, 8, G, bid, P2));
    PHASE(modulate_phase(nullptr, XCTX, MT, p.in[I_N1G] + 1024, MOD + 5 * 6144, 0, 1024, XN, gw, NGW, lane, P2, 8, MOD + 4 * 6144 + 5120, nullptr, XR));
    PHASE(run_gemm(lds, XN, (const bf16_t*)(ws + WS_WNA), MT, 3072, 1024, G, bid, EpiQKV1{U, (bf16_t*)(ws + WS_VT1)}));
    PHASE(na_phase<0>(p, lds, bid, G, tid, wave, lane));
#ifdef NA_PROBE
    xcd_barrier(xbar); na_phase<NA_PROBE>(p, lds, bid, G, tid, wave, lane); xcd_barrier(xbar);
#endif
    PHASE(run_gemm(lds, Y, (const bf16_t*)(ws + WS_WNAOUT), NLAT, 1024, 1024, G, bid, EpiRes16{nullptr, XR, MOD + 5 * 6144 + 2048}));
    PHASE(modulate_phase(nullptr, XCTX, NLAT, p.in[I_N2G] + 1024, MOD + 5 * 6144, 3072, 4096, XN, gw, NGW, lane, nullptr, 0, nullptr, nullptr, XR));
    PHASE(run_gemm(lds, XN, (const bf16_t*)(ws + WS_W1) + (size_t)FF * 1024, NLAT, FF, 1024, G, bid, EpiBf16<2>{U, FF}));
    PHASE(run_gemm(lds, U, (const bf16_t*)(ws + WS_W2) + (size_t)FF * 1024, NLAT, 1024, FF, G, bid, EpiRes16{nullptr, XR, MOD + 5 * 6144 + 5120}));
    PHASE(final_norm_phase(p, gw, NGW, lane));
#undef PHASE
}

extern "C" void kernel_launch(void* const* d_in, const int* in_sizes, int n_in, void* d_out, int out_size, void* d_ws, size_t ws_size, hipStream_t stream) {
    static int grid = 0;
    if (grid == 0) {
        if (n_in != 22 || out_size != NLAT * DM || ws_size < WS_END) { fprintf(stderr, "kernel_launch: unexpected shapes (n_in %d out %d ws %zu)\n", n_in, out_size, ws_size); grid = -1; return; }
        int dev = 0, cus = 0, per_cu = 0;
        if (hipGetDevice(&dev) != hipSuccess || hipDeviceGetAttribute(&cus, hipDeviceAttributeMultiprocessorCount, dev) != hipSuccess) { grid = -1; return; }
        if (hipFuncSetAttribute((const void*)fwd_kernel, hipFuncAttributeMaxDynamicSharedMemorySize, LDS_BYTES) != hipSuccess) { fprintf(stderr, "kernel_launch: hipFuncSetAttribute failed\n"); grid = -1; return; }
        if (hipOccupancyMaxActiveBlocksPerMultiprocessor(&per_cu, (const void*)fwd_kernel, 512, LDS_BYTES) != hipSuccess || per_cu < 1) { fprintf(stderr, "kernel_launch: occupancy query says %d\n", per_cu); per_cu = 1; }
        (void)hipGetLastError();
        grid = cus;
    }
    if (grid < 0) return;
    P a{};
    for (int i = 0; i < 22; ++i) a.in[i] = (const float*)d_in[i];
    a.out = (float*)d_out; a.ws = (unsigned char*)d_ws; a.ph_lo = 0; a.ph_hi = N_PHASES;
    void* args[] = {&a};
    hipError_t e = hipLaunchCooperativeKernel((const void*)fwd_kernel, dim3(grid), dim3(512), args, LDS_BYTES, stream);
    if (e != hipSuccess) fprintf(stderr, "cooperative launch failed: %s (grid %d)\n", hipGetErrorString(e), grid);
}
```
